# Optimizing an MI355X kernel written in HIP

```python
import math
import jax, jax.numpy as jnp
from jax import lax
import numpy as np

D_MODEL = 2048
BATCH = 2
SEQ = 4096
DEPTH = 2
DEC_BATCH = 32
DEC_SEQ = 4
PAST_LEN = 8192
PAGE_SIZE = 128

N_A_LAYERS = DEPTH // 2
N_B_LAYERS = DEPTH - N_A_LAYERS
D_RNN = (D_MODEL * 5) // 4
LRU_BLOCK = 256
N_LRU_BLOCKS = D_RNN // LRU_BLOCK
CONV_W = 4
LRU_C = 8.0
HEAD_DIM = 128
N_HEADS = D_MODEL // HEAD_DIM
KV_HEADS = 4
GROUP = N_HEADS // KV_HEADS
ATT_WIDTH = N_HEADS * HEAD_DIM
KV_WIDTH = KV_HEADS * HEAD_DIM
Q_BLOCK = 128
LOGIT_BIAS_INIT = -8.0
EPS = 1e-6

kernel_name = "yoco_rglru_stickbreaking_step"


def rms_norm(x, g):
    xf = x.astype(jnp.float32)
    y = xf * lax.rsqrt(jnp.mean(xf * xf, axis=-1, keepdims=True) + EPS)
    return (y * g.astype(jnp.float32)).astype(x.dtype)


def rglru_mixer(u, conv_buf, h0, w_in, conv_w, conv_b, w_r, b_r, w_i, b_i, lam, w_out):
    B, T, _ = u.shape
    proj = u @ w_in
    xr, gate = proj[..., :D_RNN], proj[..., D_RNN:]
    xpad = jnp.concatenate([conv_buf.astype(xr.dtype), xr], axis=1)
    xc = conv_b + xpad[:, 0:T] * conv_w[0]
    for k in range(1, CONV_W):
        xc = xc + xpad[:, k:k + T] * conv_w[k]
    new_buf = xpad[:, T:]
    xb = xc.reshape(B, T, N_LRU_BLOCKS, LRU_BLOCK)
    r = jax.nn.sigmoid(jnp.einsum('btnc,ncd->btnd', xb, w_r).reshape(B, T, D_RNN) + b_r)
    i = jax.nn.sigmoid(jnp.einsum('btnc,ncd->btnd', xb, w_i).reshape(B, T, D_RNN) + b_i)
    log_a = -LRU_C * r.astype(jnp.float32) * jax.nn.softplus(-lam.astype(jnp.float32))
    a = jnp.exp(log_a)
    b = jnp.sqrt(-jnp.expm1(2.0 * log_a)) * (i * xc).astype(jnp.float32)

    def step(h, ab):
        a_t, b_t = ab
        h = a_t * h + b_t
        return h, h

    h_last, hs = lax.scan(step, h0.astype(jnp.float32),
                          (jnp.swapaxes(a, 0, 1), jnp.swapaxes(b, 0, 1)))
    y = jnp.swapaxes(hs, 0, 1).astype(u.dtype) * jax.nn.silu(gate)
    return y @ w_out, new_buf, h_last


def stick_breaking_block(qb, qpos, k, v, kpos, bias):
    z = jnp.einsum('bqkgd,bskd->bkgqs', qb, k).astype(jnp.float32) / math.sqrt(HEAD_DIM)
    z = z + bias.astype(jnp.float32)[None, :, :, None, None]
    mask = kpos[None, :] < qpos[:, None]
    log_keep = jnp.where(mask, jax.nn.log_sigmoid(-z), 0.0)
    suffix = lax.cumsum(log_keep, axis=4, reverse=True) - log_keep
    attn = jnp.where(mask, jnp.exp(jax.nn.log_sigmoid(z) + suffix), 0.0)
    o = jnp.einsum('bkgqs,bskd->bqkgd', attn.astype(v.dtype), v)
    return o.reshape(qb.shape[0], qb.shape[1], ATT_WIDTH)


def stick_breaking_mixer(u, k, v, q_pos, k_pos, w_in, bias, w_out):
    B, T, _ = u.shape
    proj = u @ w_in
    q, gate = proj[..., :ATT_WIDTH], proj[..., ATT_WIDTH:]
    qb_len = min(Q_BLOCK, T)
    n_blk = T // qb_len
    qs = q.reshape(B, n_blk, qb_len, KV_HEADS, GROUP, HEAD_DIM).transpose(1, 0, 2, 3, 4, 5)
    ps = q_pos.reshape(n_blk, qb_len)
    bias_g = bias.reshape(KV_HEADS, GROUP)
    o = lax.map(lambda a: stick_breaking_block(a[0], a[1], k, v, k_pos, bias_g), (qs, ps))
    o = jnp.swapaxes(o, 0, 1).reshape(B, T, ATT_WIDTH)
    return (o * jax.nn.silu(gate)) @ w_out


def run_group(x, conv_state, h_state, past_k, past_v, g_pre, g_post, a_w_in, a_conv_w, a_conv_b,
              a_w_r, a_b_r, a_w_i, a_b_i, a_lambda, a_w_out, kv_norm, w_k, w_v, b_w_in, b_logit, b_w_out):
    B, T, _ = x.shape
    P = past_k.shape[1]
    q_pos = P + jnp.arange(T, dtype=jnp.int32)
    k_pos = jnp.arange(P + T, dtype=jnp.int32)
    new_bufs, new_hs = [], []
    k_new = v_new = k_all = v_all = None
    for layer in range(DEPTH):
        u = rms_norm(x, g_pre[layer])
        if layer < N_A_LAYERS:
            out, buf, hl = rglru_mixer(u, conv_state[:, layer], h_state[:, layer], a_w_in[layer],
                                       a_conv_w[layer], a_conv_b[layer], a_w_r[layer], a_b_r[layer],
                                       a_w_i[layer], a_b_i[layer], a_lambda[layer], a_w_out[layer])
            new_bufs.append(buf)
            new_hs.append(hl)
        else:
            j = layer - N_A_LAYERS
            out = stick_breaking_mixer(u, k_all, v_all, q_pos, k_pos, b_w_in[j], b_logit[j], b_w_out[j])
        x = x + rms_norm(out, g_post[layer])
        if layer == N_A_LAYERS - 1:
            s = rms_norm(x, kv_norm)
            k_new = (s @ w_k).reshape(B, T, KV_HEADS, HEAD_DIM)
            v_new = (s @ w_v).reshape(B, T, KV_HEADS, HEAD_DIM)
            k_all = jnp.concatenate([past_k.astype(k_new.dtype), k_new], axis=1)
            v_all = jnp.concatenate([past_v.astype(v_new.dtype), v_new], axis=1)
    return x, jnp.stack(new_bufs, axis=1), jnp.stack(new_hs, axis=1), k_new, v_new


def setup_inputs(seed: int = 0) -> dict:
    key = jax.random.key(seed)
    ks = jax.random.split(key, 24)
    f32 = jnp.float32
    n_pages = PAST_LEN // PAGE_SIZE
    n_used = DEC_BATCH * n_pages
    n_phys = n_used + max(1, n_used // 4)
    nrm = lambda k, shape, s: jax.random.normal(k, shape, f32) * s
    x_prompt = nrm(ks[0], (BATCH, SEQ, D_MODEL), 1.0)
    x_sample = nrm(ks[1], (DEC_BATCH, DEC_SEQ, D_MODEL), 1.0)
    cache_k = nrm(ks[2], (n_phys, PAGE_SIZE, KV_HEADS, HEAD_DIM), 1.0)
    cache_v = nrm(ks[3], (n_phys, PAGE_SIZE, KV_HEADS, HEAD_DIM), 1.0)
    state_conv = nrm(ks[4], (DEC_BATCH, N_A_LAYERS, CONV_W - 1, D_RNN), 1.0)
    state_h = nrm(ks[5], (DEC_BATCH, N_A_LAYERS, D_RNN), 0.5)
    page_table = jax.random.permutation(ks[6], n_phys)[:n_used].astype(jnp.int32).reshape(DEC_BATCH, n_pages)
    g_pre = 1.0 + nrm(ks[7], (DEPTH, D_MODEL), 0.05)
    g_post = 1.0 + nrm(ks[8], (DEPTH, D_MODEL), 0.05)
    a_w_in = nrm(ks[9], (N_A_LAYERS, D_MODEL, 2 * D_RNN), D_MODEL ** -0.5)
    a_conv_w = nrm(ks[10], (N_A_LAYERS, CONV_W, D_RNN), CONV_W ** -0.5)
    a_conv_b = nrm(ks[11], (N_A_LAYERS, D_RNN), 0.01)
    a_w_r = nrm(ks[12], (N_A_LAYERS, N_LRU_BLOCKS, LRU_BLOCK, LRU_BLOCK), LRU_BLOCK ** -0.5)
    a_b_r = nrm(ks[13], (N_A_LAYERS, D_RNN), 0.01)
    a_w_i = nrm(ks[14], (N_A_LAYERS, N_LRU_BLOCKS, LRU_BLOCK, LRU_BLOCK), LRU_BLOCK ** -0.5)
    a_b_i = nrm(ks[15], (N_A_LAYERS, D_RNN), 0.01)
    a_c = jax.random.uniform(ks[16], (N_A_LAYERS, D_RNN), f32, minval=0.9, maxval=0.999)
    a_base = a_c ** (1.0 / LRU_C)
    a_lambda = jnp.log(a_base) - jnp.log1p(-a_base)
    a_w_out = nrm(ks[17], (N_A_LAYERS, D_RNN, D_MODEL), D_RNN ** -0.5)
    kv_norm = 1.0 + nrm(ks[18], (D_MODEL,), 0.05)
    w_k = nrm(ks[19], (D_MODEL, KV_WIDTH), D_MODEL ** -0.5)
    w_v = nrm(ks[20], (D_MODEL, KV_WIDTH), D_MODEL ** -0.5)
    b_w_in = nrm(ks[21], (N_B_LAYERS, D_MODEL, 2 * ATT_WIDTH), D_MODEL ** -0.5)
    b_logit = LOGIT_BIAS_INIT + nrm(ks[23], (N_B_LAYERS, N_HEADS), 0.1)
    b_w_out = nrm(ks[22], (N_B_LAYERS, ATT_WIDTH, D_MODEL), ATT_WIDTH ** -0.5)
    return {"x_prompt": x_prompt, "x_sample": x_sample, "cache_k": cache_k, "cache_v": cache_v,
            "state_conv": state_conv, "state_h": state_h, "page_table": page_table,
            "g_pre": g_pre, "g_post": g_post, "a_w_in": a_w_in, "a_conv_w": a_conv_w,
            "a_conv_b": a_conv_b, "a_w_r": a_w_r, "a_b_r": a_b_r, "a_w_i": a_w_i, "a_b_i": a_b_i,
            "a_lambda": a_lambda, "a_w_out": a_w_out, "kv_norm": kv_norm, "w_k": w_k, "w_v": w_v,
            "b_w_in": b_w_in, "b_logit": b_logit, "b_w_out": b_w_out}


def reference(x_prompt, x_sample, cache_k, cache_v, state_conv, state_h, page_table, g_pre, g_post,
              a_w_in, a_conv_w, a_conv_b, a_w_r, a_b_r, a_w_i, a_b_i, a_lambda, a_w_out, kv_norm,
              w_k, w_v, b_w_in, b_logit, b_w_out):
    weights = (g_pre, g_post, a_w_in, a_conv_w, a_conv_b, a_w_r, a_b_r, a_w_i, a_b_i, a_lambda,
               a_w_out, kv_norm, w_k, w_v, b_w_in, b_logit, b_w_out)
    Bp = x_prompt.shape[0]
    zero_conv = jnp.zeros((Bp, N_A_LAYERS, CONV_W - 1, D_RNN), x_prompt.dtype)
    zero_h = jnp.zeros((Bp, N_A_LAYERS, D_RNN), jnp.float32)
    empty_kv = jnp.zeros((Bp, 0, KV_HEADS, HEAD_DIM), x_prompt.dtype)
    y_prompt, conv_p, h_p, k_p, v_p = run_group(x_prompt, zero_conv, zero_h, empty_kv, empty_kv, *weights)
    Bs, n_pages = page_table.shape
    past_k = cache_k[page_table].reshape(Bs, n_pages * PAGE_SIZE, KV_HEADS, HEAD_DIM)
    past_v = cache_v[page_table].reshape(Bs, n_pages * PAGE_SIZE, KV_HEADS, HEAD_DIM)
    y_sample, conv_s, h_s, k_s, v_s = run_group(x_sample, state_conv, state_h, past_k, past_v, *weights)
    return (y_prompt, y_sample, conv_p, h_p, k_p, v_p, conv_s, h_s, k_s, v_s)
```

```cpp
#include <hip/hip_runtime.h>
#include <cstdio>
#include <cstdint>

#ifndef MK_N_LAUNCHES
#define MK_N_LAUNCHES 1
#endif

namespace pg8 {
#define PG8_LAS __attribute__((address_space(3)))
typedef unsigned short bf16_t;
typedef short bf16x8 __attribute__((ext_vector_type(8)));
typedef float f32x4 __attribute__((ext_vector_type(4)));
typedef unsigned u32x4 __attribute__((ext_vector_type(4)));
typedef unsigned u32x2 __attribute__((ext_vector_type(2)));
constexpr int BM = 256, BK = 64, HALF = 128, HTB = HALF * BK * 2, STAGE_BYTES = 8 * HTB, NXCD = 8, WGM = 8;

__host__ __device__ __forceinline__ int lds_byte(int r, int c) { const int st = (r >> 4) * 2 + (c >> 5), rr = r & 15, cc = c & 31, ob = rr * 64 + cc * 2; return st * 1024 + (ob ^ (((ob >> 9) & 1) << 5)); }
__host__ __device__ __forceinline__ void stage_rc(int b, int& R, int& C) { const int st = b / 1024, sb = b % 1024, swz = sb ^ (((sb >> 9) & 1) << 5); R = (st >> 1) * 16 + swz / 64; C = (st & 1) * 32 + (swz % 64) / 2; }
__host__ __device__ __forceinline__ int perm32(int rho) { const int n = rho >> 4, i = rho & 15; return 8 * (i >> 2) + 4 * n + (i & 3); }

struct Unit { int pm, pn, nt, aux; const char* a; const char* b; };
struct Gemm { int lda, ldb; };

struct Order {
    int nMp, nN, nP, nS, G, c, ntP, ntS, pmS, ablk;
    const char* A; const char* B; size_t tstepA, tstepB, ksplit;
    bool sfirst = false;
    unsigned* sig = nullptr; int sig_lo = 0, sig_hi = 0;
    unsigned* wait_cnt = nullptr; unsigned wait_n = 0;
    __device__ void init(const bf16_t* A_, const bf16_t* B_, int lda, int ldb, int nMp_, int nN_, int K, int nsplit, int pmS_, int ablk_, int G_, int c_) {
        A = (const char*)A_; B = (const char*)B_; nMp = nMp_; nN = nN_; nP = nMp * nN; nS = nN * nsplit; G = G_; c = c_; ntP = K / BK; ntS = K / nsplit / BK; pmS = pmS_; ablk = ablk_;
        tstepA = (size_t)BM * lda * 2; tstepB = (size_t)BM * ldb * 2; ksplit = (size_t)(K / nsplit) * 2; }
    __device__ bool next(int i, Unit& u) const {
        const long L0 = (long)i * G + c; if (L0 >= nP + nS) return false;
        const long L = sfirst ? (L0 < nS ? nP + L0 : L0 - nS) : L0;
        if (L < nP) {
            int wgid = (int)L; { const int q = nP / NXCD, r = nP % NXCD, xcd = wgid % NXCD, off = wgid / NXCD; wgid = (xcd < r ? xcd * (q + 1) : r * (q + 1) + (xcd - r) * q) + off; }
            const int nig = WGM * nN, gid = wgid / nig, fm = gid * WGM, gsz = (nMp - fm) < WGM ? (nMp - fm) : WGM;
            u.pm = fm + ((wgid % nig) % gsz); u.pn = (wgid % nig) / gsz; u.nt = ntP; u.aux = 0;
            u.a = A + (size_t)u.pm * tstepA + (ablk ? (size_t)(u.pn >> 1) * 512 : (size_t)0); u.b = B + (size_t)u.pn * tstepB;
        } else {
            const int j = (int)L - nP; u.pn = j % nN; u.aux = j / nN; u.pm = pmS; u.nt = ntS;
            u.a = A + (size_t)pmS * tstepA + (size_t)u.aux * ksplit + (ablk ? (size_t)(u.pn >> 1) * 512 : (size_t)0); u.b = B + (size_t)u.pn * tstepB + (size_t)u.aux * ksplit;
        }
        return true;
    }
    __device__ __forceinline__ void a_ready(const Unit& u) const {
        if (wait_cnt && u.pm == pmS) {
            for (unsigned sp = 0; __hip_atomic_load(wait_cnt, __ATOMIC_RELAXED, __HIP_MEMORY_SCOPE_AGENT) < wait_n && sp < (1u << 20); ++sp) __builtin_amdgcn_s_sleep(2);
            __builtin_amdgcn_fence(__ATOMIC_ACQUIRE, "agent");
            asm volatile("s_waitcnt vmcnt(0)" ::: "memory");
        } }
    __device__ __forceinline__ void done(const Unit& u) const {
        if (sig && u.pm == pmS && u.pn >= sig_lo && u.pn < sig_hi) {
            asm volatile("s_waitcnt vmcnt(0)" ::: "memory");
            if ((threadIdx.x & 63) == 0) { __builtin_amdgcn_fence(__ATOMIC_RELEASE, "agent"); asm volatile("s_waitcnt vmcnt(0)" ::: "memory"); (void)__hip_atomic_fetch_add(sig, 1u, __ATOMIC_RELAXED, __HIP_MEMORY_SCOPE_AGENT); } } }
};

__device__ __forceinline__ unsigned cvt_pk_bf16(float lo, float hi) { unsigned r; asm volatile("v_cvt_pk_bf16_f32 %0, %1, %2" : "=v"(r) : "v"(lo), "v"(hi)); return r; }

template <class Epi, class Sched, bool ALIGN_EPI = false, bool SP2 = false>
__device__ __forceinline__ void gemm_phase(PG8_LAS unsigned char* lds, const Gemm g, const Sched& S, const Epi& E) {
    int tid_ = threadIdx.x; asm volatile("" : "+v"(tid_));
    const int tid = tid_, wid = __builtin_amdgcn_readfirstlane(tid >> 6), lane = tid & 63, wr = wid >> 2, wc = wid & 3, fr = lane & 15, fq = lane >> 4;
    unsigned voffA[2], voffB[2];
#pragma unroll
    for (int i = 0; i < 2; ++i) { int R, C; stage_rc(tid * 16 + i * 8192, R, C); const int Rb = Epi::PERM ? ((R & ~31) + perm32(R & 31)) : R;
        const int Ra = Epi::PERMA ? ((R & ~63) + 4 * (R & 15) + ((R >> 4) & 3)) : R;
        voffA[i] = (unsigned)(Ra * g.lda + C) * 2u; voffB[i] = (unsigned)(Rb * g.ldb + C) * 2u; }
    const size_t kstep = (size_t)(BK * 2);
    const size_t hstepA = (size_t)HALF * g.lda * 2, hstepB = (size_t)HALF * g.ldb * 2;
    const unsigned ldsw = (unsigned)wid * 1024u;
    const int aoff = lds_byte(wr * 64 + fr, fq * 8), boff = lds_byte(wc * 32 + fr, fq * 8);
#define PG8_SA(b, h) (((b) * 2 + (h)) * HTB)
#define PG8_SB(b, h) ((4 + (b) * 2 + (h)) * HTB)
#define PG8_STAGE(bufoff, gbase, voff) do { _Pragma("unroll") for (int _i = 0; _i < 2; ++_i) \
        __builtin_amdgcn_global_load_lds((const unsigned*)((const char*)(gbase) + (voff)[_i]), (PG8_LAS unsigned*)(lds + (bufoff) + ldsw + _i * 8192), 16, 0, 0); } while (0)
#define PG8_LDA(dst, b, h) do { _Pragma("unroll") for (int m = 0; m < 4; ++m) _Pragma("unroll") for (int k = 0; k < 2; ++k) dst[m][k] = *(const PG8_LAS bf16x8*)(lds + PG8_SA(b, h) + aoff + m * 2048 + k * 1024); } while (0)
#define PG8_LDB(dst, b, h) do { _Pragma("unroll") for (int n = 0; n < 2; ++n) _Pragma("unroll") for (int k = 0; k < 2; ++k) dst[n][k] = *(const PG8_LAS bf16x8*)(lds + PG8_SB(b, h) + boff + n * 2048 + k * 1024); } while (0)
#define PG8_MMA(ai, bj, At, Bt) do { __builtin_amdgcn_s_setprio(1); _Pragma("unroll") for (int m = 0; m < 4; ++m) _Pragma("unroll") for (int n = 0; n < 2; ++n) _Pragma("unroll") for (int k = 0; k < 2; ++k) \
        acc[ai][bj][m][n] = __builtin_amdgcn_mfma_f32_16x16x32_bf16(Bt[n][k], At[m][k], acc[ai][bj][m][n], 0, 0, 0); __builtin_amdgcn_s_setprio(0); } while (0)
#define PG8_WAIT_V(n) asm volatile("s_waitcnt vmcnt(" #n ")" ::: "memory")
#define PG8_WAIT_L(n) asm volatile("s_waitcnt lgkmcnt(" #n ")" ::: "memory")
#define PG8_BAR __builtin_amdgcn_s_barrier()
#define PG8_SCHED __builtin_amdgcn_sched_barrier(0)
    Unit cur, nxt; int ui = 0;
    if (!S.next(0, cur)) return;
    f32x4 acc[2][2][4][2];
#pragma unroll
    for (int a = 0; a < 2; ++a)
#pragma unroll
        for (int b = 0; b < 2; ++b)
#pragma unroll
            for (int m = 0; m < 4; ++m)
#pragma unroll
                for (int n = 0; n < 2; ++n) acc[a][b][m][n] = (f32x4){0.f, 0.f, 0.f, 0.f};
    bf16x8 At[4][2], B0[2][2], B1[2][2];
    const char* cA = cur.a; const char* cB = cur.b;
    S.a_ready(cur);
    if constexpr (SP2) {
        PG8_STAGE(PG8_SB(0, 0), cB, voffB); PG8_STAGE(PG8_SB(0, 1), cB + hstepB, voffB); PG8_STAGE(PG8_SA(0, 0), cA, voffA); PG8_STAGE(PG8_SA(0, 1), cA + hstepA, voffA);
        if (wr == 1) PG8_BAR;
        PG8_WAIT_V(2); PG8_BAR;
        PG8_STAGE(PG8_SB(1, 0), cB + kstep, voffB); PG8_STAGE(PG8_SA(1, 0), cA + kstep, voffA); PG8_STAGE(PG8_SB(1, 1), cB + hstepB + kstep, voffB);
        PG8_WAIT_V(6); PG8_BAR;
    } else {
        PG8_STAGE(PG8_SB(0, 0), cB, voffB); PG8_STAGE(PG8_SA(0, 0), cA, voffA); PG8_STAGE(PG8_SB(0, 1), cB + hstepB, voffB); PG8_STAGE(PG8_SA(0, 1), cA + hstepA, voffA);
        if (wr == 1) PG8_BAR;
        PG8_WAIT_V(4); PG8_BAR;
        PG8_STAGE(PG8_SB(1, 0), cB + kstep, voffB); PG8_STAGE(PG8_SA(1, 0), cA + kstep, voffA); PG8_STAGE(PG8_SB(1, 1), cB + hstepB + kstep, voffB);
        PG8_WAIT_V(6); PG8_BAR;
    }
    for (;;) {
        const bool has_next = S.next(ui + 1, nxt);
        const char* nA = has_next ? nxt.a : cA; const char* nB = has_next ? nxt.b : cB;
        const int nt = cur.nt;
        for (int t = 0; t < nt; t += 2) {
            const bool last = (t == nt - 2);
            const char* a1 = cA + (size_t)(t + 1) * kstep;
            const char* a2 = last ? nA : cA + (size_t)(t + 2) * kstep; const char* b2 = last ? nB : cB + (size_t)(t + 2) * kstep;
            const char* a3 = a2 + kstep; const char* b3 = b2 + kstep;
            if (last && has_next) S.a_ready(nxt);
            if constexpr (SP2) {
            PG8_LDB(B0, 0, 0); PG8_LDB(B1, 0, 1); PG8_SCHED; PG8_LDA(At, 0, 0); PG8_STAGE(PG8_SA(1, 1), a1 + hstepA, voffA);
            PG8_WAIT_V(8); PG8_WAIT_L(0); PG8_BAR; PG8_MMA(0, 0, At, B0); PG8_MMA(0, 1, At, B1); PG8_BAR; PG8_SCHED;
            PG8_LDA(At, 0, 1); PG8_STAGE(PG8_SB(0, 0), b2, voffB); PG8_STAGE(PG8_SB(0, 1), b2 + hstepB, voffB); PG8_STAGE(PG8_SA(0, 0), a2, voffA);
            PG8_WAIT_V(8); PG8_WAIT_L(0); PG8_BAR; PG8_MMA(1, 0, At, B0); PG8_MMA(1, 1, At, B1); PG8_BAR; PG8_SCHED;
            PG8_LDB(B0, 1, 0); PG8_LDB(B1, 1, 1); PG8_SCHED; PG8_LDA(At, 1, 0); PG8_STAGE(PG8_SA(0, 1), a2 + hstepA, voffA);
            PG8_WAIT_V(8); PG8_WAIT_L(0); PG8_BAR; PG8_MMA(0, 0, At, B0); PG8_MMA(0, 1, At, B1); PG8_BAR; PG8_SCHED;
            PG8_LDA(At, 1, 1); PG8_STAGE(PG8_SB(1, 0), b3, voffB); PG8_STAGE(PG8_SB(1, 1), b3 + hstepB, voffB); PG8_STAGE(PG8_SA(1, 0), a3, voffA);
            PG8_WAIT_V(8); PG8_WAIT_L(0); PG8_BAR; PG8_MMA(1, 0, At, B0); PG8_MMA(1, 1, At, B1); PG8_BAR; PG8_SCHED;
            } else {
            PG8_LDB(B0, 0, 0); PG8_SCHED; PG8_LDA(At, 0, 0); PG8_STAGE(PG8_SA(1, 1), a1 + hstepA, voffA);
            PG8_WAIT_L(8); PG8_BAR; PG8_WAIT_L(0); PG8_MMA(0, 0, At, B0); PG8_BAR; PG8_SCHED;
            PG8_LDB(B1, 0, 1); PG8_STAGE(PG8_SB(0, 0), b2, voffB);
            PG8_BAR; PG8_WAIT_L(0); PG8_MMA(0, 1, At, B1); PG8_BAR;
            PG8_LDA(At, 0, 1); PG8_STAGE(PG8_SA(0, 0), a2, voffA);
            PG8_BAR; PG8_WAIT_L(0); PG8_MMA(1, 0, At, B0); PG8_BAR; PG8_SCHED;
            PG8_STAGE(PG8_SB(0, 1), b2 + hstepB, voffB);
            PG8_WAIT_V(6); PG8_BAR; PG8_MMA(1, 1, At, B1); PG8_BAR;
            PG8_LDB(B0, 1, 0); PG8_SCHED; PG8_LDA(At, 1, 0); PG8_STAGE(PG8_SA(0, 1), a2 + hstepA, voffA);
            PG8_WAIT_L(8); PG8_BAR; PG8_WAIT_L(0); PG8_MMA(0, 0, At, B0); PG8_BAR; PG8_SCHED;
            PG8_LDB(B1, 1, 1); PG8_STAGE(PG8_SB(1, 0), b3, voffB);
            PG8_BAR; PG8_WAIT_L(0); PG8_MMA(0, 1, At, B1); PG8_BAR;
            PG8_LDA(At, 1, 1); PG8_STAGE(PG8_SA(1, 0), a3, voffA);
            PG8_BAR; PG8_WAIT_L(0); PG8_MMA(1, 0, At, B0); PG8_BAR; PG8_SCHED;
            PG8_STAGE(PG8_SB(1, 1), b3 + hstepB, voffB);
            PG8_WAIT_V(6); PG8_BAR; PG8_MMA(1, 1, At, B1); PG8_BAR;
            }
        }
        if constexpr (ALIGN_EPI) { if (wr == 0) PG8_BAR; }
        E(acc, cur, wr, wc, fr, fq); S.done(cur);
        if (!has_next) break;
#pragma unroll
        for (int a = 0; a < 2; ++a)
#pragma unroll
            for (int b = 0; b < 2; ++b)
#pragma unroll
                for (int m = 0; m < 4; ++m)
#pragma unroll
                    for (int n = 0; n < 2; ++n) acc[a][b][m][n] = (f32x4){0.f, 0.f, 0.f, 0.f};
        cur = nxt; cA = nA; cB = nB; ++ui;
        if constexpr (ALIGN_EPI) { if (wr == 1) PG8_BAR; }
    }
    PG8_WAIT_V(0);
    if constexpr (!ALIGN_EPI) { if (wr == 0) PG8_BAR; }
    PG8_BAR;
#undef PG8_SA
#undef PG8_SB
#undef PG8_STAGE
#undef PG8_LDA
#undef PG8_LDB
#undef PG8_MMA
#undef PG8_WAIT_V
#undef PG8_WAIT_L
#undef PG8_BAR
#undef PG8_SCHED
}
}

constexpr int NWAVES = 8;
constexpr int N_LAUNCHES = MK_N_LAUNCHES;
constexpr int NPHASE = 13;
constexpr int DM = 2048, SEQ = 4096, MPROMPT = 8192, MSAMP = 128, MREAL = 8320, MPAD = 8448;
constexpr int DR = 2560;
constexpr int HD = 128, KVW = 512;
constexpr int NPG = 64;
constexpr float EPS = 1e-6f;
constexpr float LOG2E = 1.4426950408889634f;
constexpr float QSCALE = 1.4426950408889634f / 11.313708498984761f;
constexpr float MASKV = -1.0e30f;
constexpr size_t O_YP = 0, O_YS = 16777216, O_CVP = 17039360, O_HP = 17054720, O_KP = 17059840, O_VP = 21254144, O_CVS = 25448448, O_HS = 25694208, O_KS = 25776128, O_VS = 25841664, O_END = 25907200;
constexpr size_t MiB = 1u << 20;
#if defined(PROBE_EXTRA) || MK_N_LAUNCHES != 1
constexpr size_t WS_CTL = 0, CTL_ZERO_BYTES = 1 * MiB;
#else
constexpr size_t WS_CTL = 0, CTL_ZERO_BYTES = (size_t)(4096 + 3456) * 4;
#endif
constexpr size_t WS_W1T = 2 * MiB, WS_WGT = 22 * MiB, WS_W3T = 25 * MiB, WS_W4T = 35 * MiB, WS_W5T = 55 * MiB;
constexpr size_t WS_CL = 63 * MiB, WS_SA = 64 * MiB, WS_SB = 65 * MiB, WS_LT = 66 * MiB, WS_PO = 67 * MiB;
constexpr size_t WS_XN = 84 * MiB, WS_XR = 117 * MiB, WS_GT = 159 * MiB, WS_XC = 201 * MiB, WS_Y = 243 * MiB;
constexpr size_t WS_AL = 285 * MiB, WS_BB = 368 * MiB, WS_OUT = 451 * MiB, WS_X1 = 517 * MiB;
constexpr size_t WS_KB = 583 * MiB, WS_VT = 592 * MiB, WS_QB = 600 * MiB, WS_G2 = 633 * MiB, WS_AO = 666 * MiB, WS_OUTS = 700 * MiB, WS_END = 724 * MiB;
constexpr int CW_BAR = 4096;
constexpr int CW_SIG = 2048;
constexpr int CW_CMB = 1024;
constexpr int RING_OFF = 0, RING_BYTES = 131072;
constexpr int LDSCTL_OFF = RING_BYTES, MISC_OFF = LDSCTL_OFF + 320;
constexpr int LDS_BYTES = 147456;

#define GAS __attribute__((address_space(1)))
#define LAS __attribute__((address_space(3)))
typedef unsigned short bf16;
typedef unsigned v4u __attribute__((ext_vector_type(4)));
typedef unsigned v2u __attribute__((ext_vector_type(2)));
typedef float f32x4 __attribute__((ext_vector_type(4)));
typedef float f32x16 __attribute__((ext_vector_type(16)));
typedef short bf16x8 __attribute__((ext_vector_type(8)));
typedef short s16x4 __attribute__((ext_vector_type(4)));
typedef GAS unsigned gu32;
#define RLX_AGENT __ATOMIC_RELAXED, __HIP_MEMORY_SCOPE_AGENT
#define LDS_WAIT() asm volatile("s_waitcnt lgkmcnt(0)" ::: "memory")
__device__ __forceinline__ unsigned f2bf(float f) { unsigned u = __builtin_bit_cast(unsigned, f); return (u + 0x7fffu + ((u >> 16) & 1u)) >> 16; }
typedef float f32x2_t __attribute__((ext_vector_type(2))); typedef __bf16 bf16x2_t __attribute__((ext_vector_type(2)));
__device__ __forceinline__ unsigned pk2(float lo, float hi) { f32x2_t v = {lo, hi}; bf16x2_t b = __builtin_convertvector(v, bf16x2_t); return __builtin_bit_cast(unsigned, b); }
__device__ __forceinline__ float bf2f(unsigned short b) { return __builtin_bit_cast(float, (unsigned)b << 16); }
__device__ __forceinline__ float bflo(unsigned w) { return __builtin_bit_cast(float, w << 16); }
__device__ __forceinline__ float bfhi(unsigned w) { return __builtin_bit_cast(float, w & 0xffff0000u); }
__device__ __forceinline__ float ex2(float x) { return __builtin_amdgcn_exp2f(x); }
__device__ __forceinline__ float lg2(float x) { return __builtin_amdgcn_logf(x); }
__device__ __forceinline__ float sigmoid_f(float x) { return __builtin_amdgcn_rcpf(1.f + ex2(-LOG2E * x)); }
__device__ __forceinline__ float silu_f(float x) { return x * sigmoid_f(x); }

#define XB_TMO      128
#define XB_XCNT(j)  (256  + 64 * (j))
#define XB_XSUB(j)  (1280 + 64 * (j))
#define XB_XGEN(j)  (2304 + 64 * (j))
#define XB_TOP      3328
#define XB_TOPGEN   3392
#define XCD_BAR_WORDS 3456
#define XB_SPIN_CAP (1u << 18)
__device__ __forceinline__ unsigned xb_ld(unsigned* p)              { return __hip_atomic_load(p, __ATOMIC_RELAXED, __HIP_MEMORY_SCOPE_AGENT); }
__device__ __forceinline__ unsigned xb_add(unsigned* p, unsigned v) { return __hip_atomic_fetch_add(p, v, __ATOMIC_RELAXED, __HIP_MEMORY_SCOPE_AGENT); }
__device__ __forceinline__ unsigned xb_xcc_id() { return (unsigned)__builtin_amdgcn_s_getreg((3 << 11) | 20) & 0xFu; }
#define XB_SPIN(cond, bar) do { unsigned _sp = 0; while (cond) { __builtin_amdgcn_s_sleep(1); \
    if ((++_sp & 255u) == 0u) { if (xb_ld(&(bar)[XB_TMO])) break; if (_sp > XB_SPIN_CAP) { atomicAdd(&(bar)[XB_TMO], 1u); break; } } } } while (0)
struct XcdBarrier { unsigned* bar; unsigned x; volatile LAS unsigned* st; };
__device__ __forceinline__ XcdBarrier xcd_barrier_post(unsigned* bar, volatile LAS unsigned* st) {
    XcdBarrier b; b.bar = bar; b.x = xb_xcc_id(); b.st = st;
    if (threadIdx.x == 0) (void)xb_add(&bar[XB_XCNT(b.x)], 1u);
    return b;
}
__device__ __forceinline__ void xcd_barrier_complete(unsigned* bar, unsigned x, unsigned& nloc, unsigned& nx) {
    const unsigned G = gridDim.x * gridDim.y * gridDim.z;
    unsigned sum, cnt, mine, sp = 0u;
    for (;;) {
        sum = 0u; cnt = 0u; mine = 0u;
#pragma unroll
        for (unsigned j = 0; j < 16; ++j) { const unsigned c = xb_ld(&bar[XB_XCNT(j)]); sum += c; cnt += (c > 0u) ? 1u : 0u; mine = (j == x) ? c : mine; }
        if (sum == G) break;
        __builtin_amdgcn_s_sleep(1);
        if ((++sp & 255u) == 0u) { if (xb_ld(&bar[XB_TMO])) break; if (sp > XB_SPIN_CAP) { atomicAdd(&bar[XB_TMO], 1u); break; } }
    }
    nloc = mine > 0u ? mine : 1u; nx = cnt > 0u ? cnt : 1u;
}
__device__ __forceinline__ void xcd_barrier(const XcdBarrier& b) {
    asm volatile("s_waitcnt vmcnt(0)" ::: "memory");
    __syncthreads();
    if (threadIdx.x == 0) {
        unsigned* bar = b.bar;
        __builtin_amdgcn_s_waitcnt(0);
        unsigned nloc = b.st[0], nx = b.st[1];
        if (nloc == 0u) { xcd_barrier_complete(bar, b.x, nloc, nx); b.st[0] = nloc; b.st[1] = nx; }
        const unsigned old = xb_add(&bar[XB_XSUB(b.x)], 1u);
        const unsigned gen = old / nloc;
        if (old + 1u == (gen + 1u) * nloc) {
            __builtin_amdgcn_fence(__ATOMIC_RELEASE, "agent");
            asm volatile("s_waitcnt vmcnt(0)" ::: "memory");
            const unsigned og = xb_add(&bar[XB_TOP], 1u);
            const unsigned tg = og / nx;
            if (og + 1u == (tg + 1u) * nx) xb_add(&bar[XB_TOPGEN], 1u);
            else XB_SPIN(xb_ld(&bar[XB_TOPGEN]) == tg, bar);
            __builtin_amdgcn_fence(__ATOMIC_ACQUIRE, "agent");
            xb_add(&bar[XB_XGEN(b.x)], 1u);
            asm volatile("s_waitcnt vmcnt(0)" ::: "memory");
        } else {
            XB_SPIN(xb_ld(&bar[XB_XGEN(b.x)]) == gen, bar);
            __builtin_amdgcn_fence(__ATOMIC_ACQUIRE, "agent");
            asm volatile("s_waitcnt vmcnt(0)" ::: "memory");
        }
    }
    __syncthreads();
}

using pg8::Unit;
struct EpiG1 {
    static constexpr bool PERM = true, AFTER_DRAIN = false, PERMA = false;
    bf16* XR; bf16* GT;
    __device__ __forceinline__ void operator()(const f32x4 (&acc)[2][2][4][2], const Unit& u, int wr, int wc, int fr, int fq) const {
        const bool gate = u.pn >= 10; bf16* base = gate ? GT : XR; const int colt = (gate ? u.pn - 10 : u.pn) * 256;
        const int row0 = u.pm * 256 + wr * 64 + fr, col0 = colt + wc * 32 + 8 * fq;
#pragma unroll
        for (int ai = 0; ai < 2; ++ai)
#pragma unroll
            for (int m = 0; m < 4; ++m) { bf16* rowp = base + (size_t)(row0 + ai * 128 + m * 16) * DR + col0;
#pragma unroll
                for (int bj = 0; bj < 2; ++bj) { f32x4 v0 = acc[ai][bj][m][0], v1 = acc[ai][bj][m][1];
                    if (gate) {
#pragma unroll
                        for (int j = 0; j < 4; ++j) { v0[j] = silu_f(v0[j]); v1[j] = silu_f(v1[j]); } }
                    v4u w; w.x = pk2(v0[0], v0[1]); w.y = pk2(v0[2], v0[3]); w.z = pk2(v1[0], v1[1]); w.w = pk2(v1[2], v1[3]);
                    *(v4u*)(rowp + bj * 128) = w; } }
    }
};
struct EpiF32 {
    static constexpr bool PERM = false, AFTER_DRAIN = false, PERMA = false;
    float* O; float* OS; int ldc;
    __device__ __forceinline__ void operator()(const f32x4 (&acc)[2][2][4][2], const Unit& u, int wr, int wc, int fr, int fq) const {
        float* base = (u.pm == 32) ? OS + (size_t)u.aux * 256 * ldc : O + (size_t)u.pm * 256 * ldc;
        const int row0 = wr * 64 + fr, col0 = u.pn * 256 + wc * 32 + 4 * fq;
#pragma unroll
        for (int ai = 0; ai < 2; ++ai)
#pragma unroll
            for (int m = 0; m < 4; ++m) { float* rowp = base + (size_t)(row0 + ai * 128 + m * 16) * ldc + col0;
#pragma unroll
                for (int bj = 0; bj < 2; ++bj)
#pragma unroll
                    for (int n = 0; n < 2; ++n) *(f32x4*)(rowp + bj * 128 + n * 16) = acc[ai][bj][m][n]; }
    }
};
struct EpiOut {
    static constexpr bool PERM = true, AFTER_DRAIN = false, PERMA = false;
    bf16* OB; float* OS; int ldc;
    __device__ __forceinline__ void operator()(const f32x4 (&acc)[2][2][4][2], const Unit& u, int wr, int wc, int fr, int fq) const {
        const int row0 = wr * 64 + fr, col0 = u.pn * 256 + wc * 32 + 8 * fq;
        if (u.pm == 32) { float* base = OS + (size_t)u.aux * 256 * ldc;
#pragma unroll
            for (int ai = 0; ai < 2; ++ai)
#pragma unroll
                for (int m = 0; m < 4; ++m) { float* rowp = base + (size_t)(row0 + ai * 128 + m * 16) * ldc + col0;
#pragma unroll
                    for (int bj = 0; bj < 2; ++bj) { *(f32x4*)(rowp + bj * 128) = acc[ai][bj][m][0]; *(f32x4*)(rowp + bj * 128 + 4) = acc[ai][bj][m][1]; } }
        } else { bf16* base = OB + (size_t)u.pm * 256 * ldc;
#pragma unroll
            for (int ai = 0; ai < 2; ++ai)
#pragma unroll
                for (int m = 0; m < 4; ++m) { bf16* rowp = base + (size_t)(row0 + ai * 128 + m * 16) * ldc + col0;
#pragma unroll
                    for (int bj = 0; bj < 2; ++bj) { const f32x4 v0 = acc[ai][bj][m][0], v1 = acc[ai][bj][m][1];
                        v4u w; w.x = pk2(v0[0], v0[1]); w.y = pk2(v0[2], v0[3]); w.z = pk2(v1[0], v1[1]); w.w = pk2(v1[2], v1[3]); *(v4u*)(rowp + bj * 128) = w; } }
        }
    }
};
__device__ __forceinline__ float dpp_shr(float old, float x, int sh) {
    const int o = __builtin_bit_cast(int, old), v = __builtin_bit_cast(int, x); int r;
    switch (sh) { case 1: r = __builtin_amdgcn_update_dpp(o, v, 0x111, 0xf, 0xf, false); break; case 2: r = __builtin_amdgcn_update_dpp(o, v, 0x112, 0xf, 0xf, false); break;
                  case 4: r = __builtin_amdgcn_update_dpp(o, v, 0x114, 0xf, 0xf, false); break; default: r = __builtin_amdgcn_update_dpp(o, v, 0x118, 0xf, 0xf, false); break; }
    return __builtin_bit_cast(float, r); }
struct EpiLru {
    static constexpr bool PERM = false, AFTER_DRAIN = false, PERMA = true;
    const bf16* XC; unsigned* AB; const float* b_r; const float* b_i; const float* cl; float* SA; float* SB; LAS float* xch;
    __device__ __forceinline__ void operator()(const f32x4 (&acc)[2][2][4][2], const Unit& u, int wr, int wc, int fr, int fq) const {
        const int chl = wc * 32 + 4 * fq, chb = u.pn * 128 + chl, trow = u.pm * 256 + wr * 64 + 4 * fr;
#pragma unroll
        for (int ai = 0; ai < 2; ++ai)
#pragma unroll
            for (int n = 0; n < 2; ++n) {
                const f32x4 br = *(const f32x4*)(b_r + chb + 16 * n), bi = *(const f32x4*)(b_i + chb + 16 * n), c4 = *(const f32x4*)(cl + chb + 16 * n);
                float As[4] = {1.f, 1.f, 1.f, 1.f}, Bs[4] = {0.f, 0.f, 0.f, 0.f};
#pragma unroll
                for (int m = 0; m < 4; ++m) { const size_t ro = (size_t)(trow + ai * 128 + m) * DR + chb + 16 * n;
                    const v2u xw = *(const v2u*)(XC + ro);
                    const float xc[4] = {bflo(xw.x), bfhi(xw.x), bflo(xw.y), bfhi(xw.y)};
                    const f32x4 ar = acc[ai][0][m][n] + br, ig = acc[ai][1][m][n] + bi;
                    v4u w;
#pragma unroll
                    for (int j = 0; j < 4; ++j) { const float r = sigmoid_f(ar[j]), ii = sigmoid_f(ig[j]); const float la = r * c4[j], a = ex2(la); const float om = __builtin_fmaf(-a, a, 1.0f);
                        const float bb = __builtin_amdgcn_sqrtf(__builtin_fmaxf(om, 0.f)) * ii * xc[j];
                        w[j] = pk2(la, bb);
                        Bs[j] = a * Bs[j] + bb; As[j] *= a; }
                    *(v4u*)(AB + ro) = w; }
#pragma unroll
                for (int j = 0; j < 4; ++j)
#pragma unroll
                    for (int sh = 1; sh < 16; sh <<= 1) { const float Al = dpp_shr(1.0f, As[j], sh), Bl = dpp_shr(0.0f, Bs[j], sh); Bs[j] = Bl * As[j] + Bs[j]; As[j] = Al * As[j]; }
                if (fr == 15) {
#pragma unroll
                    for (int j = 0; j < 4; ++j) { LAS float* p = xch + ((ai * 2 + wr) * 128 + chl + 16 * n + j) * 2; p[0] = As[j]; p[1] = Bs[j]; } }
            }
        asm volatile("s_waitcnt lgkmcnt(0)" ::: "memory"); __builtin_amdgcn_s_barrier(); asm volatile("" ::: "memory");
        const int t = (wr * 4 + wc) * 64 + fq * 16 + fr;
        if (t < 256 && u.pm < 32) { const int ai = t >> 7, c = t & 127; const LAS float* p0 = xch + ((ai * 2 + 0) * 128 + c) * 2; const LAS float* p1 = xch + ((ai * 2 + 1) * 128 + c) * 2;
            const float A0 = p0[0], B0 = p0[1], A1 = p1[0], B1 = p1[1];
            const size_t so = (size_t)((u.pm >> 4) * 32 + (u.pm & 15) * 2 + ai) * DR + u.pn * 128 + c;
            SA[so] = A0 * A1; SB[so] = B0 * A1 + B1; }
    }
};
struct EpiG4 {
    static constexpr bool PERM = false, AFTER_DRAIN = false, PERMA = false;
    float* out; bf16* KB; bf16* VT; bf16* QB; bf16* G2;
    __device__ __forceinline__ void operator()(const f32x4 (&acc)[2][2][4][2], const Unit& u, int wr, int wc, int fr, int fq) const {
        const int row0 = u.pm * 256 + wr * 64 + fr, pn = u.pn;
#pragma unroll
        for (int ai = 0; ai < 2; ++ai)
#pragma unroll
            for (int m = 0; m < 4; ++m) { const int row = row0 + ai * 128 + m * 16;
#pragma unroll
                for (int bj = 0; bj < 2; ++bj)
#pragma unroll
                    for (int n = 0; n < 2; ++n) { const int col = pn * 256 + bj * 128 + wc * 32 + n * 16 + 4 * fq; const f32x4 v = acc[ai][bj][m][n];
                        if (pn < 2) { const int cc = col;
                            if (row < MPROMPT) { *(f32x4*)(out + O_KP + (size_t)row * KVW + cc) = v; v2u w; w.x = pk2(v[0], v[1]); w.y = pk2(v[2], v[3]); *(v2u*)(KB + (size_t)row * KVW + cc) = w; }
                            else if (row < MREAL) *(f32x4*)(out + O_KS + (size_t)(row - MPROMPT) * KVW + cc) = v;
                        } else if (pn < 4) { const int cc = col - 512;
                            if (row < MPROMPT) { *(f32x4*)(out + O_VP + (size_t)row * KVW + cc) = v; const int b = row >> 12, t0 = row & 4095, t = (t0 & ~12) | ((t0 & 4) << 1) | ((t0 & 8) >> 1);
                                bf16* vt = VT + ((size_t)(b * 4 + (cc >> 7)) * 128 + (cc & 127)) * SEQ + t;
#pragma unroll
                                for (int j = 0; j < 4; ++j) vt[(size_t)j * SEQ] = (bf16)f2bf(v[j]); }
                            else if (row < MREAL) *(f32x4*)(out + O_VS + (size_t)(row - MPROMPT) * KVW + cc) = v;
                        } else if (pn < 12) { v2u w; w.x = pk2(v[0], v[1]); w.y = pk2(v[2], v[3]); *(v2u*)(QB + (size_t)row * DM + (col - 1024)) = w;
                        } else { v2u w; w.x = pk2(silu_f(v[0]), silu_f(v[1])); w.y = pk2(silu_f(v[2]), silu_f(v[3])); *(v2u*)(G2 + (size_t)row * DM + (col - 3072)) = w; } } }
    }
};

__device__ __forceinline__ float wave_sum(float v) {
#pragma unroll
    for (int o = 1; o < 64; o <<= 1) v += __shfl_xor(v, o);
    return v;
}
__device__ __forceinline__ void tr_item(const float* W, int ldw, int K, int nblk, bf16* WT, int item, const float* gain, float scale, LAS float* scr, int lane) {
    const int kb = item / nblk, nb = item % nblk, k0 = 64 * kb, n0 = 32 * nb;
    float wv[32];
#pragma unroll
    for (int i = 0; i < 32; ++i) wv[i] = W[(size_t)(k0 + 2 * i + (lane >> 5)) * ldw + n0 + (lane & 31)];
#pragma unroll
    for (int i = 0; i < 32; ++i) { const int kk = 2 * i + (lane >> 5); const float g = gain ? gain[k0 + kk] * scale : scale; scr[kk * 33 + (lane & 31)] = wv[i] * g; }
    LDS_WAIT(); asm volatile("" ::: "memory");
    const int c = lane & 7;
#pragma unroll
    for (int j = 0; j < 4; ++j) { const int n = (lane >> 3) + 8 * j; const LAS float* s = scr + (8 * c) * 33 + n;
        v4u o; o.x = pk2(s[0 * 33], s[1 * 33]); o.y = pk2(s[2 * 33], s[3 * 33]); o.z = pk2(s[4 * 33], s[5 * 33]); o.w = pk2(s[6 * 33], s[7 * 33]);
        *(GAS v4u*)(WT + (size_t)(n0 + n) * K + k0 + 8 * c) = o; }
    LDS_WAIT(); asm volatile("" ::: "memory");
}
__device__ __forceinline__ void load_row8(const float* p, int lane, f32x4 (&v)[8]) {
#pragma unroll
    for (int j = 0; j < 8; ++j) v[j] = ((const f32x4*)p)[64 * j + lane];
}
__device__ __forceinline__ void load_row8_bf16(const bf16* p, int lane, f32x4 (&v)[8]) {
#pragma unroll
    for (int j = 0; j < 8; ++j) { const v2u w = ((const v2u*)p)[64 * j + lane]; v[j] = (f32x4){bflo(w.x), bfhi(w.x), bflo(w.y), bfhi(w.y)}; }
}
__device__ __forceinline__ float sumsq8(const f32x4 (&v)[8]) { float s = 0.f;
#pragma unroll
    for (int j = 0; j < 8; ++j) s += (v[j].x * v[j].x + v[j].y * v[j].y) + (v[j].z * v[j].z + v[j].w * v[j].w);
    return s; }
__device__ __forceinline__ void store_row8_bf16(bf16* o, int lane, const f32x4 (&v)[8], float s) {
#pragma unroll
    for (int j = 0; j < 8; ++j) { v2u w; w.x = pk2(v[j].x * s, v[j].y * s); w.y = pk2(v[j].z * s, v[j].w * s); ((v2u*)o)[64 * j + lane] = w; }
}
__device__ __forceinline__ void unpack8(const v4u w, float (&x)[8]) { x[0] = bflo(w.x); x[1] = bfhi(w.x); x[2] = bflo(w.y); x[3] = bfhi(w.y); x[4] = bflo(w.z); x[5] = bfhi(w.z); x[6] = bflo(w.w); x[7] = bfhi(w.w); }

namespace sba {
constexpr int KROW = 272, VROW = 144, KT_BYTES = 64 * KROW, VT_BYTES = 128 * VROW;
constexpr int KB0 = 0, VB0 = 3 * KT_BYTES;
__device__ __forceinline__ int crow(int r, int hi) { return (r & 3) + 8 * (r >> 2) + 4 * hi; }
#define SB() __builtin_amdgcn_sched_barrier(0)
__device__ __forceinline__ v4u lds128(const LAS unsigned char* p) { return *(const LAS v4u*)p; }
template <bool QK, bool PV>
__device__ __forceinline__ void hstep(const LAS unsigned char* kpN, const LAS unsigned char* vpP, const LAS unsigned char* vpC, const bf16x8 (&qf)[8], const bf16x8 (&td)[2], float bias2, float& R,
                                      const bf16x8 (&paP)[2], f32x16& pc, bf16x8 (&paO)[2], f32x16 (&o)[4], v4u (&vpre)[3]) {
    v4u vf[8], kf[8]; unsigned lw[8], pw[8];
    if (PV) { vf[0] = vpre[0]; vf[1] = vpre[1]; vf[2] = vpre[2]; }
    f32x16 pn;
#pragma unroll
    for (int r = 0; r < 16; ++r) pn[r] = bias2;
    const float z0 = pc[0];
#pragma unroll
    for (int i = 0; i < 8; ++i) {
        if (i <= 4) { if (PV) vf[i + 3] = lds128(vpP + ((i + 3) >> 1) * 32 * VROW + ((i + 3) & 1) * 32); }
        else if (QK) kf[i - 5] = lds128(kpN + (i - 5) * 32);
        if (PV) o[i >> 1] = __builtin_amdgcn_mfma_f32_32x32x16_bf16(paP[i & 1], __builtin_bit_cast(bf16x8, vf[i]), o[i >> 1], 0, 0, 0);
        lw[i] = pk2(lg2(1.0f + ex2(pc[2 * i])), lg2(1.0f + ex2(pc[2 * i + 1]))); asm volatile("" : "+v"(lw[i]));
        SB();
    }
    pc = __builtin_amdgcn_mfma_f32_32x32x16_bf16(td[0], __builtin_bit_cast(bf16x8, (v4u){lw[0], lw[1], lw[2], lw[3]}), pc, 0, 0, 0);
    pc = __builtin_amdgcn_mfma_f32_32x32x16_bf16(td[1], __builtin_bit_cast(bf16x8, (v4u){lw[4], lw[5], lw[6], lw[7]}), pc, 0, 0, 0);
    SB();
#pragma unroll
    for (int i = 0; i < 8; ++i) {
        if (i <= 4) { if (QK) kf[i + 3] = lds128(kpN + (i + 3) * 32); }
        else vpre[i - 5] = lds128(vpC + ((i - 5) >> 1) * 32 * VROW + ((i - 5) & 1) * 32);
        if (QK) pn = __builtin_amdgcn_mfma_f32_32x32x16_bf16(__builtin_bit_cast(bf16x8, kf[i]), qf[i], pn, 0, 0, 0);
        if (i >= 2) { pw[i - 2] = pk2(ex2(pc[2 * i - 4] + R), ex2(pc[2 * i - 3] + R)); asm volatile("" : "+v"(pw[i - 2])); }
        SB();
    }
    pw[6] = pk2(ex2(pc[12] + R), ex2(pc[13] + R)); pw[7] = pk2(ex2(pc[14] + R), ex2(pc[15] + R));
    { const float tot = pc[0] - z0;
      const unsigned tb = __builtin_bit_cast(unsigned, tot); auto rr = __builtin_amdgcn_permlane32_swap(tb, tb, false, false); R += __builtin_bit_cast(float, (unsigned)rr[0]); }
    paO[0] = __builtin_bit_cast(bf16x8, (v4u){pw[0], pw[1], pw[2], pw[3]}); paO[1] = __builtin_bit_cast(bf16x8, (v4u){pw[4], pw[5], pw[6], pw[7]});
    pc = pn;
    SB();
}
__device__ __forceinline__ void p_unit(int b, int h, int qb, const bf16* QB, const bf16* KB, const bf16* VT, const bf16* G2, bf16* AO, float bias2, LAS unsigned char* lds) {
    int tid_ = threadIdx.x; asm volatile("" : "+v"(tid_));
    const int tid = tid_, lane = tid & 63, ql = lane & 31, h2 = lane >> 5; const int wid = __builtin_amdgcn_readfirstlane(tid >> 6);
    const int kvh = h >> 2, q0w = qb * 256 + wid * 32;
    const size_t rowbase = (size_t)b * SEQ;
    bf16x8 qf[8];
    { const bf16* qp = QB + (rowbase + q0w + ql) * DM + h * HD + 8 * h2;
#pragma unroll
      for (int s = 0; s < 8; ++s) qf[s] = *(const bf16x8*)(qp + 16 * s); }
    bf16x8 tdiag[2];
#pragma unroll
    for (int s = 0; s < 2; ++s)
#pragma unroll
        for (int j = 0; j < 8; ++j) { const int ki = 16 * s + 8 * (j >> 2) + 4 * h2 + (j & 3); tdiag[s][j] = (ki >= ql) ? (short)0xBF80 : (short)0; }
    f32x16 o[4];
#pragma unroll
    for (int d = 0; d < 4; ++d) o[d] = f32x16{};
    float R = 0.f;
    const int NT = 4 * (qb + 1);
    const bf16* kg = KB + rowbase * KVW + kvh * HD; const bf16* vg = VT + (size_t)(b * 4 + kvh) * HD * SEQ;
    v4u kr[2], vr[2];
    auto gloadk = [&](int tt) {
#pragma unroll
        for (int i = 0; i < 2; ++i) { const int cid = tid + 512 * i; kr[i] = *(const v4u*)(kg + (size_t)(64 * tt + (cid >> 4)) * KVW + (cid & 15) * 8); } };
    auto gloadv = [&](int tt) {
#pragma unroll
        for (int i = 0; i < 2; ++i) { const int cid = tid + 512 * i; vr[i] = *(const v4u*)(vg + (size_t)(cid >> 3) * SEQ + 64 * tt + (cid & 7) * 8); } };
    auto lstorek = [&](int koff) {
#pragma unroll
        for (int i = 0; i < 2; ++i) { const int cid = tid + 512 * i; *(LAS v4u*)(lds + koff + (cid >> 4) * KROW + (cid & 15) * 16) = kr[i]; } };
    auto lstorev = [&](int voff) {
#pragma unroll
        for (int i = 0; i < 2; ++i) { const int cid = tid + 512 * i; *(LAS v4u*)(lds + voff + (cid >> 3) * VROW + (cid & 7) * 16) = vr[i]; } };
    int kc = KB0, kn = KB0 + KT_BYTES, kf = KB0 + 2 * KT_BYTES, vo = VB0, vc = VB0 + VT_BYTES, vf = VB0 + 2 * VT_BYTES;
    gloadk(NT - 1); gloadv(NT - 1); lstorek(kc); lstorev(vc); gloadk(NT - 2); lstorek(kn);
    __syncthreads();
#define P_ROT() do { const int t_ = kc; kc = kn; kn = kf; kf = t_; const int u_ = vo; vo = vc; vc = vf; vf = u_; } while (0)
    auto qk = [&](const LAS unsigned char* kb, int blk) -> f32x16 {
        f32x16 p;
#pragma unroll
        for (int r = 0; r < 16; ++r) p[r] = bias2;
        const LAS unsigned char* kp = kb + (32 * blk + ql) * KROW + h2 * 16;
#pragma unroll
        for (int s = 0; s < 8; ++s) { const bf16x8 k0 = *(const LAS bf16x8*)(kp + s * 32); p = __builtin_amdgcn_mfma_f32_32x32x16_bf16(k0, qf[s], p, 0, 0, 0); }
        return p; };
    auto pv = [&](const LAS unsigned char* vb, int blk, const bf16x8 (&pa)[2]) {
        const LAS unsigned char* vp = vb + ql * VROW + h2 * 16 + blk * 64;
        v4u f[8];
#pragma unroll
        for (int i = 0; i < 8; ++i) f[i] = lds128(vp + (i >> 1) * 32 * VROW + (i & 1) * 32);
#pragma unroll
        for (int i = 0; i < 8; ++i) o[i >> 1] = __builtin_amdgcn_mfma_f32_32x32x16_bf16(pa[i & 1], __builtin_bit_cast(bf16x8, f[i]), o[i >> 1], 0, 0, 0);
    };
    const int gdiag = 8 * qb + wid;
    const int lv = ql * VROW + h2 * 16, lk = ql * KROW + h2 * 16;
    f32x16 pc; bf16x8 paP[2], paA[2]; v4u vpre[3];
#pragma unroll
    for (int r = 0; r < 16; ++r) pc[r] = 0.f;
    paP[0] = __builtin_bit_cast(bf16x8, (v4u){0u, 0u, 0u, 0u}); paP[1] = paP[0]; paA[0] = paP[0]; paA[1] = paP[0];
    vpre[0] = vpre[1] = vpre[2] = (v4u){0u, 0u, 0u, 0u};
    auto dmask = [&](f32x16& p) {
#pragma unroll
        for (int r = 0; r < 16; ++r) if ((r & 3) + 8 * (r >> 2) + 4 * h2 >= ql) p[r] = MASKV; };
#define P_HALF(QKF, g, kcur, blkc, kpn, vpp, vpcur, pin, pout) do { \
        if ((g) <= gdiag) { const bool st_ = (g) == gdiag;        \
            if (st_) { pc = qk(kcur, blkc); dmask(pc); } \
            hstep<QKF, true>(kpn, st_ ? (vpcur) : (vpp), vpcur, qf, tdiag, bias2, R, pin, pc, pout, o, vpre); } } while (0)
    int tt = NT - 1;
    for (; tt >= NT - 4 && tt >= 1; --tt) {
        if (tt > 1) gloadk(tt - 2);
        gloadv(tt - 1);
        P_HALF(true, 2 * tt + 1, lds + kc, 1, lds + kc + lk, lds + vo + lv, lds + vc + lv + 64, paP, paA);
        P_HALF(true, 2 * tt, lds + kc, 0, lds + kn + lk + 32 * KROW, lds + vc + lv + 64, lds + vc + lv, paA, paP);
        if (tt > 1) lstorek(kf);
        lstorev(vf);
        __syncthreads();
        P_ROT();
    }
    for (; tt >= 1; --tt) {
        if (tt > 1) gloadk(tt - 2);
        gloadv(tt - 1);
        hstep<true, true>(lds + kc + lk, lds + vo + lv, lds + vc + lv + 64, qf, tdiag, bias2, R, paP, pc, paA, o, vpre);
        hstep<true, true>(lds + kn + lk + 32 * KROW, lds + vc + lv + 64, lds + vc + lv, qf, tdiag, bias2, R, paA, pc, paP, o, vpre);
        if (tt > 1) lstorek(kf);
        lstorev(vf);
        __syncthreads();
        P_ROT();
    }
    P_HALF(true, 1, lds + kc, 1, lds + kc + lk, lds + vo + lv, lds + vc + lv + 64, paP, paA);
    P_HALF(false, 0, lds + kc, 0, lds + kc + lk, lds + vc + lv + 64, lds + vc + lv, paA, paP);
    pv(lds + vc, 0, paP);
    __syncthreads();
#undef P_HALF
#undef P_ROT
    {
        LAS float* ost = (LAS float*)(lds + wid * 16384);
#pragma unroll
        for (int d = 0; d < 4; ++d)
#pragma unroll
            for (int r = 0; r < 16; ++r) ost[crow(r, h2) * 128 + d * 32 + ql] = o[d][r];
        LDS_WAIT();
        const int rq = lane >> 4, c8 = (lane & 15) * 8;
#pragma unroll
        for (int i = 0; i < 8; ++i) { const int q = rq + 4 * i; const f32x4 a = *(const LAS f32x4*)(ost + q * 128 + c8), c = *(const LAS f32x4*)(ost + q * 128 + c8 + 4);
            const size_t off = (rowbase + q0w + q) * DM + h * HD + c8; const v4u g = *(const v4u*)(G2 + off);
            v4u w; w.x = pk2(a[0] * bflo(g.x), a[1] * bfhi(g.x)); w.y = pk2(a[2] * bflo(g.y), a[3] * bfhi(g.y)); w.z = pk2(c[0] * bflo(g.z), c[1] * bfhi(g.z)); w.w = pk2(c[2] * bflo(g.w), c[3] * bfhi(g.w));
            *(v4u*)(AO + off) = w; }
        LDS_WAIT();
        __syncthreads();
    }
}

__device__ __forceinline__ void s_waveunit(int wu, const float* CK, const float* CV, const int* PT, const bf16* QB, const float* blogit, float* PO, float* LT, LAS unsigned char* kl) {
    int lane_ = threadIdx.x & 63; asm volatile("" : "+v"(lane_));
    const int lane = lane_, n = lane & 15, kq = lane >> 4;
    const int pair = wu >> 4, c = wu & 15, sb = pair >> 2, kvh = pair & 3;
    const int head = kvh * 4 + (n & 3), mrow = MPROMPT + sb * 4 + (n >> 2);
    bf16x8 qf[4];
    { const bf16* qp = QB + (size_t)mrow * DM + head * HD + 8 * kq;
#pragma unroll
      for (int sl = 0; sl < 4; ++sl) qf[sl] = *(const bf16x8*)(qp + 32 * sl); }
    const float bias2 = blogit[head] * LOG2E;
    bf16x8 tA, tB, tN;
#pragma unroll
    for (int j = 0; j < 8; ++j) { const short m1 = (short)0xBF80;
        tA[j] = (j >= 4) ? m1 : ((4 * kq + j >= n) ? m1 : (short)0);
        tB[j] = (j >= 4) ? ((4 * kq + (j - 4) >= n) ? m1 : (short)0) : (short)0;
        tN[j] = m1; }
    f32x4 o[2][4];
#pragma unroll
    for (int hf = 0; hf < 2; ++hf)
#pragma unroll
        for (int i = 0; i < 4; ++i) o[hf][i] = (f32x4){0.f, 0.f, 0.f, 0.f};
    float R = 0.f;
    const int pg0 = __builtin_amdgcn_readfirstlane(PT[sb * NPG + 4 * c]), pg1 = __builtin_amdgcn_readfirstlane(PT[sb * NPG + 4 * c + 1]), pg2 = __builtin_amdgcn_readfirstlane(PT[sb * NPG + 4 * c + 2]), pg3 = __builtin_amdgcn_readfirstlane(PT[sb * NPG + 4 * c + 3]);
    f32x4 kr[2][4][2], vr[2][8];
    auto tokbase = [&](int blk) -> size_t { const int pgi = blk >> 2, page = pgi == 0 ? pg0 : pgi == 1 ? pg1 : pgi == 2 ? pg2 : pg3; return (size_t)page * 128 + ((32 * blk) & 127); };
    auto loadk = [&](int blk) { const size_t tb = tokbase(blk);
#pragma unroll
        for (int h = 0; h < 2; ++h)
#pragma unroll
            for (int sl = 0; sl < 4; ++sl) { const f32x4* kp = (const f32x4*)(CK + ((tb + 16 * h + 4 * sl + kq) * 4 + kvh) * HD + 4 * n); kr[h][sl][0] = *(kp); kr[h][sl][1] = *(kp + 16); } };
    auto loadv = [&](int blk) { const size_t tb = tokbase(blk);
#pragma unroll
        for (int j = 0; j < 8; ++j) { const int key = (j < 4) ? 4 * kq + j : 16 + 4 * kq + (j - 4); const f32x4* vp = (const f32x4*)(CV + ((tb + key) * 4 + kvh) * HD + 4 * n);
            vr[0][j] = *(vp); vr[1][j] = *(vp + 16); } };
    f32x4 z[2]; bf16x8 pb;
    auto qk_part = [&]() {
#pragma unroll
        for (int h = 0; h < 2; ++h)
#pragma unroll
            for (int sl = 0; sl < 4; ++sl) { const f32x4 a = kr[h][sl][0], b = kr[h][sl][1]; LAS unsigned char* kw = kl + (16 * h + 4 * sl + kq) * 272 + 8 * n;
                *(LAS v2u*)kw = (v2u){pk2(a[0], a[1]), pk2(a[2], a[3])}; *(LAS v2u*)(kw + 128) = (v2u){pk2(b[0], b[1]), pk2(b[2], b[3])}; }
#pragma unroll
        for (int h = 0; h < 2; ++h) { z[h] = (f32x4){bias2, bias2, bias2, bias2};
#pragma unroll
            for (int sl = 0; sl < 4; ++sl) { const bf16x8 kf = *(const LAS bf16x8*)(kl + (16 * h + n) * 272 + 64 * sl + 16 * kq);
                z[h] = __builtin_amdgcn_mfma_f32_16x16x32_bf16(kf, qf[sl], z[h], 0, 0, 0); } } };
    auto sb_part = [&]() {
        float L[8];
#pragma unroll
        for (int r = 0; r < 4; ++r) { L[r] = lg2(1.0f + ex2(z[0][r])); L[4 + r] = lg2(1.0f + ex2(z[1][r])); }
        v4u lw; lw.x = pk2(L[0], L[1]); lw.y = pk2(L[2], L[3]); lw.z = pk2(L[4], L[5]); lw.w = pk2(L[6], L[7]);
        const bf16x8 lb = __builtin_bit_cast(bf16x8, lw);
        f32x4 cA = z[0] + R, cB = z[1] + R, tot = (f32x4){0.f, 0.f, 0.f, 0.f};
        cA = __builtin_amdgcn_mfma_f32_16x16x32_bf16(tA, lb, cA, 0, 0, 0);
        cB = __builtin_amdgcn_mfma_f32_16x16x32_bf16(tB, lb, cB, 0, 0, 0);
        tot = __builtin_amdgcn_mfma_f32_16x16x32_bf16(tN, lb, tot, 0, 0, 0);
        v4u pw; pw.x = pk2(ex2(cA[0]), ex2(cA[1])); pw.y = pk2(ex2(cA[2]), ex2(cA[3])); pw.z = pk2(ex2(cB[0]), ex2(cB[1])); pw.w = pk2(ex2(cB[2]), ex2(cB[3]));
        pb = __builtin_bit_cast(bf16x8, pw);
        R += tot[0]; };
    auto pv_part = [&]() {
#pragma unroll
        for (int hf = 0; hf < 2; ++hf)
#pragma unroll
            for (int i = 0; i < 4; ++i) { v4u w; w.x = pk2(vr[hf][0][i], vr[hf][1][i]); w.y = pk2(vr[hf][2][i], vr[hf][3][i]); w.z = pk2(vr[hf][4][i], vr[hf][5][i]); w.w = pk2(vr[hf][6][i], vr[hf][7][i]);
                o[hf][i] = __builtin_amdgcn_mfma_f32_16x16x32_bf16(__builtin_bit_cast(bf16x8, w), pb, o[hf][i], 0, 0, 0); } };
    loadk(15); loadv(15);
    for (int blk = 15; blk >= 1; --blk) {
        qk_part(); __builtin_amdgcn_sched_barrier(0);
        loadk(blk - 1); __builtin_amdgcn_sched_barrier(0);
        sb_part(); pv_part(); __builtin_amdgcn_sched_barrier(0);
        loadv(blk - 1); __builtin_amdgcn_sched_barrier(0);
    }
    qk_part(); sb_part(); pv_part();
    float* po = PO + ((size_t)wu * 16 + n) * HD;
#pragma unroll
    for (int hf = 0; hf < 2; ++hf)
#pragma unroll
        for (int r = 0; r < 4; ++r) *(f32x4*)(po + 64 * hf + 16 * kq + 4 * r) = (f32x4){o[hf][0][r], o[hf][1][r], o[hf][2][r], o[hf][3][r]};
    if (kq == 0) LT[wu * 16 + n] = R;
}

__device__ __forceinline__ void s_combine(int pair, const float* out, const bf16* QB, const bf16* G2, const float* blogit, const float* PO, const float* LT, bf16* AO) {
    const int t = threadIdx.x, n = t >> 5, d = 4 * (t & 31);
    const int sb = pair >> 2, kvh = pair & 3, itok = n >> 2, head = kvh * 4 + (n & 3), mrow = MPROMPT + sb * 4 + itok;
    const size_t qoff = (size_t)mrow * DM + head * HD + d;
    const v2u qw = *(const v2u*)(QB + qoff);
    const float q4[4] = {bflo(qw.x), bfhi(qw.x), bflo(qw.y), bfhi(qw.y)};
    const float bias2 = blogit[head] * LOG2E;
    float R = 0.f; f32x4 O = (f32x4){0.f, 0.f, 0.f, 0.f};
#pragma unroll
    for (int j = 3; j >= 0; --j) {
        const f32x4 k4 = *(const f32x4*)(out + O_KS + (size_t)(sb * 4 + j) * KVW + kvh * HD + d);
        float part = (q4[0] * k4[0] + q4[1] * k4[1]) + (q4[2] * k4[2] + q4[3] * k4[3]);
#pragma unroll
        for (int s = 1; s < 32; s <<= 1) part += __shfl_xor(part, s);
        if (j < itok) { const float z = part + bias2, L = lg2(1.0f + ex2(z)); R -= L; const float P = ex2(z + R);
            const f32x4 v4 = *(const f32x4*)(out + O_VS + (size_t)(sb * 4 + j) * KVW + kvh * HD + d); O += v4 * P; }
    }
    for (int c = 15; c >= 0; --c) { const float w = ex2(R); const f32x4 po = *(const f32x4*)(PO + ((size_t)(pair * 16 + c) * 16 + n) * HD + d); O += po * w; R += LT[(pair * 16 + c) * 16 + n]; }
    const v2u gw = *(const v2u*)(G2 + qoff);
    v2u w; w.x = pk2(O[0] * bflo(gw.x), O[1] * bfhi(gw.x)); w.y = pk2(O[2] * bflo(gw.y), O[3] * bfhi(gw.y));
    *(v2u*)(AO + qoff) = w;
}
}

struct Args { const float* in[24]; float* out; unsigned char* ws; int ph_lo, ph_hi, li, mode; };
__global__ void __launch_bounds__(NWAVES * 64, 2) yoco_fwd(Args args) {
    extern __shared__ __attribute__((aligned(16))) unsigned char lds_raw[];
    LAS unsigned char* lds = (LAS unsigned char*)lds_raw;
    volatile LAS unsigned* MISC = (volatile LAS unsigned*)(lds + MISC_OFF);
    const int tid0 = threadIdx.x;
    const int G = gridDim.x; const int bx = blockIdx.x; const int vcu = (G % 8 == 0) ? (bx % 8) * (G / 8) + bx / 8 : bx;
    unsigned char* ws = args.ws; float* out = args.out;
    gu32* ctl = (gu32*)(ws + WS_CTL);
    const float* x_prompt = args.in[0]; const float* x_sample = args.in[1]; const float* cache_k = args.in[2]; const float* cache_v = args.in[3];
    const float* state_conv = args.in[4]; const float* state_h = args.in[5]; const int* page_table = (const int*)args.in[6];
    const float* g_pre = args.in[7]; const float* g_post = args.in[8]; const float* a_w_in = args.in[9]; const float* a_conv_w = args.in[10]; const float* a_conv_b = args.in[11];
    const float* a_w_r = args.in[12]; const float* a_b_r = args.in[13]; const float* a_w_i = args.in[14]; const float* a_b_i = args.in[15]; const float* a_lambda = args.in[16];
    const float* a_w_out = args.in[17]; const float* kv_norm = args.in[18]; const float* w_k = args.in[19]; const float* w_v = args.in[20]; const float* b_w_in = args.in[21];
    const float* b_logit = args.in[22]; const float* b_w_out = args.in[23];
    bf16* W1T = (bf16*)(ws + WS_W1T); bf16* WGT = (bf16*)(ws + WS_WGT); bf16* W3T = (bf16*)(ws + WS_W3T); bf16* W4T = (bf16*)(ws + WS_W4T); bf16* W5T = (bf16*)(ws + WS_W5T);
    float* CL = (float*)(ws + WS_CL); float* SA = (float*)(ws + WS_SA); float* SB = (float*)(ws + WS_SB); float* LT = (float*)(ws + WS_LT); float* PO = (float*)(ws + WS_PO);
    bf16* XN = (bf16*)(ws + WS_XN); bf16* XR = (bf16*)(ws + WS_XR); bf16* GT = (bf16*)(ws + WS_GT); bf16* XC = (bf16*)(ws + WS_XC); bf16* Y = (bf16*)(ws + WS_Y);
    unsigned* AB = (unsigned*)(ws + WS_AL); bf16* OUTB = (bf16*)(ws + WS_OUT); float* OUTS = (float*)(ws + WS_OUTS); bf16* X1B = (bf16*)(ws + WS_X1);
    bf16* KB = (bf16*)(ws + WS_KB); bf16* VT = (bf16*)(ws + WS_VT); bf16* QB = (bf16*)(ws + WS_QB); bf16* G2 = (bf16*)(ws + WS_G2); bf16* AO = (bf16*)(ws + WS_AO);

    for (int u = tid0; u < (LDS_BYTES - LDSCTL_OFF) / 4; u += NWAVES * 64) ((LAS unsigned*)(lds + LDSCTL_OFF))[u] = 0u;
    __syncthreads();
    const int lo = args.ph_lo, hi = args.ph_hi;
    XcdBarrier bar; bar.bar = (unsigned*)(ctl + CW_BAR) + args.li * XCD_BAR_WORDS; bar.x = 0; bar.st = nullptr;
    if (hi - lo > 1) bar = xcd_barrier_post((unsigned*)(ctl + CW_BAR) + args.li * XCD_BAR_WORDS, MISC + 8);
#define GRID_BAR() xcd_barrier(bar)
#ifndef TEST_ONLY_PHASE
#define TEST_ONLY_PHASE -1
#endif
#define IN(k) ((TEST_ONLY_PHASE < 0 || TEST_ONLY_PHASE == (k)) && lo <= (k) && (k) < hi)
#define BOTH(k) (IN(k) && IN((k) + 1))
    const int NGW = G * NWAVES, NGT = G * NWAVES * 64;
#define EARLY_S(G_, bx_) ((G_) == 256 && (bx_) >= 660 - 2 * 256)
#define PHASE_IDS() int tid_p = threadIdx.x; asm volatile("" : "+v"(tid_p)); const int tid = tid_p, lane = tid & 63, wave = __builtin_amdgcn_readfirstlane(tid >> 6), gw = vcu * NWAVES + wave, gt = vcu * (NWAVES * 64) + tid; (void)lane; (void)gw; (void)gt

    if (IN(0)) {
        PHASE_IDS();
        LAS float* scr = (LAS float*)(lds + RING_OFF + wave * 16384);
        constexpr int I_W1 = 32 * 160, I_WG = 40 * 16, NITEMS = I_W1 + I_WG;
        for (int it = gw; it < NITEMS; it += NGW) {
            int r = it;
            if (r < I_W1) { tr_item(a_w_in, 5120, 2048, 160, W1T, r, g_pre, 1.0f, scr, lane); continue; } r -= I_W1;
            const int sm = r >> 4, hb = sm >> 1, gi = sm & 1, nb = hb >> 1, hf = hb & 1;
            tr_item((gi ? a_w_i : a_w_r) + (size_t)nb * 65536 + 128 * hf, 256, 256, 4, WGT + (size_t)(hb * 256 + gi * 128) * 256, r & 15, nullptr, 1.0f, scr, lane);
        }
        for (int ch = gt; ch < DR; ch += NGT) CL[ch] = -8.0f * LOG2E * log1pf(expf(-a_lambda[ch]));
        for (int m = gw; m < MPAD; m += NGW) {
            bf16* orow = XN + (size_t)m * DM;
            if (m < MREAL) { const float* xr = (m < MPROMPT) ? x_prompt + (size_t)m * DM : x_sample + (size_t)(m - MPROMPT) * DM;
                f32x4 v[8]; load_row8(xr, lane, v); const float rs = 1.0f / sqrtf(wave_sum(sumsq8(v)) * (1.0f / DM) + EPS); store_row8_bf16(orow, lane, v, rs); }
            else {
#pragma unroll
                for (int j = 0; j < 8; ++j) ((v2u*)orow)[64 * j + lane] = (v2u){0u, 0u}; }
        }
        if (BOTH(0)) GRID_BAR();
    }
    if (IN(1)) {
        pg8::Gemm g{2048, 2048}; pg8::Order S; S.init(XN, W1T, 2048, 2048, 32, 20, 2048, 1, 32, 0, G, bx);
        EpiG1 E{XR, GT};
        pg8::gemm_phase<EpiG1, pg8::Order, true, true>(lds + RING_OFF, g, S, E);
        const int nbusy = (S.nP + S.nS) - ((S.nP + S.nS - 1) / G) * G;
        if (bx >= nbusy) {
            int tid_d = threadIdx.x; asm volatile("" : "+v"(tid_d)); const int lane_d = tid_d & 63, wave_d = __builtin_amdgcn_readfirstlane(tid_d >> 6);
            LAS float* scr = (LAS float*)(lds + RING_OFF + wave_d * 16384);
            constexpr int I_W3 = 40 * 64, I_WK = 32 * 16, I_WQ = 32 * 64, I_W5 = 32 * 64, NDEF = I_W3 + 2 * I_WK + 2 * I_WQ + I_W5;
            for (int it = (bx - nbusy) * NWAVES + wave_d; it < NDEF; it += (G - nbusy) * NWAVES) {
                int r = it;
                if (r < I_W3) { tr_item(a_w_out, 2048, 2560, 64, W3T, r, nullptr, 1.0f, scr, lane_d); continue; } r -= I_W3;
                if (r < I_WK) { tr_item(w_k, 512, 2048, 16, W4T, r, kv_norm, 1.0f, scr, lane_d); continue; } r -= I_WK;
                if (r < I_WK) { tr_item(w_v, 512, 2048, 16, W4T + (size_t)512 * 2048, r, kv_norm, 1.0f, scr, lane_d); continue; } r -= I_WK;
                if (r < I_WQ) { tr_item(b_w_in, 4096, 2048, 64, W4T + (size_t)1024 * 2048, r, g_pre + DM, QSCALE, scr, lane_d); continue; } r -= I_WQ;
                if (r < I_WQ) { tr_item(b_w_in + 2048, 4096, 2048, 64, W4T + (size_t)3072 * 2048, r, g_pre + DM, 1.0f, scr, lane_d); continue; } r -= I_WQ;
                tr_item(b_w_out, 2048, 2048, 64, W5T, r, nullptr, 1.0f, scr, lane_d);
            }
        }
        if (BOTH(1)) GRID_BAR();
    }
    if (IN(2)) {
        PHASE_IDS();
        for (int task = gt; task < 256 * 320 + 32 * 320; task += NGT) {
            const bool samp = task >= 256 * 320; const int tk = samp ? task - 256 * 320 : task; const int rb = tk / 320, cg = tk % 320, ch = 8 * cg;
            float w[4][8], cb[8], x3[8], x2[8], x1[8];
#pragma unroll
            for (int k = 0; k < 4; ++k) { const f32x4 a = *(const f32x4*)(a_conv_w + k * DR + ch), b = *(const f32x4*)(a_conv_w + k * DR + ch + 4);
                w[k][0] = a.x; w[k][1] = a.y; w[k][2] = a.z; w[k][3] = a.w; w[k][4] = b.x; w[k][5] = b.y; w[k][6] = b.z; w[k][7] = b.w; }
            { const f32x4 a = *(const f32x4*)(a_conv_b + ch), b = *(const f32x4*)(a_conv_b + ch + 4); cb[0] = a.x; cb[1] = a.y; cb[2] = a.z; cb[3] = a.w; cb[4] = b.x; cb[5] = b.y; cb[6] = b.z; cb[7] = b.w; }
            int m0, nrows;
            if (!samp) { m0 = 32 * rb; nrows = 32;
                if ((m0 & 4095) != 0) { unpack8(*(const v4u*)(XR + (size_t)(m0 - 3) * DR + ch), x3); unpack8(*(const v4u*)(XR + (size_t)(m0 - 2) * DR + ch), x2); unpack8(*(const v4u*)(XR + (size_t)(m0 - 1) * DR + ch), x1); }
                else {
#pragma unroll
                    for (int j = 0; j < 8; ++j) { x3[j] = 0.f; x2[j] = 0.f; x1[j] = 0.f; } }
            } else { m0 = MPROMPT + 4 * rb; nrows = 4; const float* sc = state_conv + (size_t)rb * 3 * DR + ch;
#pragma unroll
                for (int j = 0; j < 8; ++j) { x3[j] = sc[j]; x2[j] = sc[DR + j]; x1[j] = sc[2 * DR + j]; } }
            for (int r0 = 0; r0 < nrows; r0 += 4) {
                v4u xw[4];
#pragma unroll
                for (int i = 0; i < 4; ++i) xw[i] = *(const v4u*)(XR + (size_t)(m0 + r0 + i) * DR + ch);
#pragma unroll
                for (int i = 0; i < 4; ++i) {
                    float x0[8]; unpack8(xw[i], x0);
                    float xc[8];
#pragma unroll
                    for (int j = 0; j < 8; ++j) { xc[j] = cb[j] + w[0][j] * x3[j] + w[1][j] * x2[j] + w[2][j] * x1[j] + w[3][j] * x0[j]; x3[j] = x2[j]; x2[j] = x1[j]; x1[j] = x0[j]; }
                    v4u o; o.x = pk2(xc[0], xc[1]); o.y = pk2(xc[2], xc[3]); o.z = pk2(xc[4], xc[5]); o.w = pk2(xc[6], xc[7]);
                    *(v4u*)(XC + (size_t)(m0 + r0 + i) * DR + ch) = o;
                }
            }
            float* so = nullptr;
            if (samp) so = out + O_CVS + (size_t)rb * 3 * DR + ch;
            else if (((m0 + 32) & 4095) == 0) so = out + O_CVP + (size_t)(m0 >> 12) * 3 * DR + ch;
            if (so) {
#pragma unroll
                for (int j = 0; j < 8; ++j) { so[j] = x3[j]; so[DR + j] = x2[j]; so[2 * DR + j] = x1[j]; } }
        }
        if (BOTH(2)) GRID_BAR();
    }
    if (IN(3)) {
        pg8::Gemm g{DR, 256}; pg8::Order S; S.init(XC, WGT, DR, 256, 32, 20, 256, 1, 32, 1, G, bx);
        EpiLru E{XC, AB, a_b_r, a_b_i, CL, SA, SB, (LAS float*)(lds + LDSCTL_OFF + 1024)};
        pg8::gemm_phase<EpiLru, pg8::Order, true, true>(lds + RING_OFF, g, S, E);
        if (BOTH(3)) GRID_BAR();
    }
    if (IN(5)) {
        PHASE_IDS();
        for (int task = gt; task < 96 * (DR / 2); task += NGT) {
            if (task >= 64 * (DR / 2)) {
                const int ts = task - 64 * (DR / 2), sb = ts / (DR / 2), ch = 2 * (ts % (DR / 2)); const f32x2_t h0s = *(const f32x2_t*)(state_h + (size_t)sb * DR + ch); float h[2] = {h0s.x, h0s.y};
#pragma unroll
                for (int i = 0; i < 4; ++i) { const size_t o = (size_t)(MPROMPT + sb * 4 + i) * DR + ch; const v2u w = *(const v2u*)(AB + o); const unsigned g = *(const unsigned*)(GT + o);
                    h[0] = ex2(bflo(w.x)) * h[0] + bfhi(w.x); h[1] = ex2(bflo(w.y)) * h[1] + bfhi(w.y); *(unsigned*)(Y + o) = pk2(h[0] * bflo(g), h[1] * bfhi(g)); }
                *(f32x2_t*)(out + O_HS + (size_t)sb * DR + ch) = (f32x2_t){h[0], h[1]};
                continue; }
            const int bc = task / (DR / 2), ch = 2 * (task % (DR / 2)), b = bc >> 5, c = bc & 31; const size_t m0 = (size_t)b * SEQ + c * 128;
            float h0 = 0.f, h1 = 0.f;
            for (int cc0 = 0; cc0 < c; cc0 += 8) {
                f32x2_t sa[8], sb2[8];
#pragma unroll
                for (int j = 0; j < 8; ++j) { const int cc = (cc0 + j < c) ? cc0 + j : c - 1; sa[j] = *(const f32x2_t*)(SA + (size_t)(b * 32 + cc) * DR + ch); sb2[j] = *(const f32x2_t*)(SB + (size_t)(b * 32 + cc) * DR + ch); }
#pragma unroll
                for (int j = 0; j < 8; ++j) if (cc0 + j < c) { h0 = sa[j].x * h0 + sb2[j].x; h1 = sa[j].y * h1 + sb2[j].y; } }
            const unsigned* ap = AB + m0 * DR + ch; const bf16* gp = GT + m0 * DR + ch; bf16* yp = Y + m0 * DR + ch;
            for (int t = 0; t < 128; t += 16) { v2u w[16]; unsigned gg[16];
#pragma unroll
                for (int j = 0; j < 16; ++j) { w[j] = *(const v2u*)(ap + (size_t)(t + j) * DR); gg[j] = *(const unsigned*)(gp + (size_t)(t + j) * DR); }
#pragma unroll
                for (int j = 0; j < 16; ++j) { h0 = ex2(bflo(w[j].x)) * h0 + bfhi(w[j].x); h1 = ex2(bflo(w[j].y)) * h1 + bfhi(w[j].y); *(unsigned*)(yp + (size_t)(t + j) * DR) = pk2(h0 * bflo(gg[j]), h1 * bfhi(gg[j])); } }
            if (c == 31) *(f32x2_t*)(out + O_HP + (size_t)b * DR + ch) = (f32x2_t){h0, h1};
        }
        if (BOTH(5)) GRID_BAR();
    }
    if (IN(6)) {
        pg8::Gemm g{DR, DR}; pg8::Order S; S.init(Y, W3T, DR, DR, 32, 8, DR, 10, 32, 0, G, bx);
        EpiOut E{OUTB, OUTS, DM};
        pg8::gemm_phase<EpiOut, pg8::Order, true, true>(lds + RING_OFF, g, S, E);
        if (BOTH(6)) GRID_BAR();
    }
    if (IN(7)) {
        PHASE_IDS();
        f32x4 gp[8]; load_row8(g_post, lane, gp);
        for (int m = gw; m < MREAL; m += NGW) {
            const float* xr = (m < MPROMPT) ? x_prompt + (size_t)m * DM : x_sample + (size_t)(m - MPROMPT) * DM;
            f32x4 o[8], x[8]; load_row8(xr, lane, x);
            if (m < MPROMPT) load_row8_bf16(OUTB + (size_t)m * DM, lane, o);
            else { load_row8(OUTS + (size_t)(m - MPROMPT) * DM, lane, o);
                for (int sp = 1; sp < 10; ++sp) { f32x4 t[8]; load_row8(OUTS + ((size_t)sp * 256 + (m - MPROMPT)) * DM, lane, t);
#pragma unroll
                    for (int j = 0; j < 8; ++j) o[j] += t[j]; } }
            const float rs = 1.0f / sqrtf(wave_sum(sumsq8(o)) * (1.0f / DM) + EPS);
#pragma unroll
            for (int j = 0; j < 8; ++j) x[j] = x[j] + o[j] * rs * gp[j];
            store_row8_bf16(X1B + (size_t)m * DM, lane, x, 1.0f);
            const float rs2 = 1.0f / sqrtf(wave_sum(sumsq8(x)) * (1.0f / DM) + EPS);
            store_row8_bf16(XN + (size_t)m * DM, lane, x, rs2);
        }
        if (BOTH(7)) GRID_BAR();
    }
    if (IN(8)) {
        unsigned* sig = (unsigned*)(ctl + CW_SIG + 64 * args.li);
        pg8::Gemm g{2048, 2048}; pg8::Order S; S.init(XN, W4T, 2048, 2048, 32, 20, 2048, 1, 32, 0, G, bx);
        S.sfirst = true; S.sig = sig; S.sig_lo = 4; S.sig_hi = 12;
        EpiG4 E{out, KB, VT, QB, G2};
        pg8::gemm_phase<EpiG4, pg8::Order, true, true>(lds + RING_OFF, g, S, E);
        if (EARLY_S(G, bx)) {
            PHASE_IDS();
            for (unsigned sp = 0; __hip_atomic_load(sig, __ATOMIC_RELAXED, __HIP_MEMORY_SCOPE_AGENT) < 64u && sp < (1u << 20); ++sp) __builtin_amdgcn_s_sleep(2);
            __builtin_amdgcn_fence(__ATOMIC_ACQUIRE, "agent");
            asm volatile("s_waitcnt vmcnt(0)" ::: "memory");
            if (wave < 4) for (int g8 = gw; g8 < 2048; g8 += NGW) { const int j = g8 >> 2; sba::s_waveunit((((j >> 4) * 4 + (g8 & 3)) << 4) | (j & 15), cache_k, cache_v, page_table, QB, b_logit, PO, LT, lds + RING_OFF + wave * 8704); }
        }
        if (BOTH(8)) GRID_BAR();
    }
    if (IN(9)) {
        PHASE_IDS();
        const int spos = (vcu % 5 == 0) ? 0 : (vcu % 5 == 4) ? 2 : 1;
        const bool early = EARLY_S(G, bx);
        for (int step = 0; step < 3; ++step) {
            if (step == spos && !(args.mode & 1) && (!early || wave >= 4)) for (int g8 = gw; g8 < 2048; g8 += NGW) { const int j = g8 >> 2; sba::s_waveunit((((j >> 4) * 4 + (g8 & 3)) << 4) | (j & 15), cache_k, cache_v, page_table, QB, b_logit, PO, LT, lds + RING_OFF + wave * 8704); }
            if (step == spos && !(args.mode & 1)) __syncthreads();
            if (step < 2 && !(args.mode & 2)) {
                if (G == 256) {
                    const int x = vcu >> 5, j = vcu & 31, t = j >> 2, b = x >> 2, h = (x & 3) * 4 + (j & 3);
                    const int qa = (t == 0) ? 13 : (t == 1) ? 12 : (t == 2) ? 11 : (t == 3) ? 8 : (t == 4) ? 7 : (t == 5) ? 15 : (t == 6) ? 14 : 10;
                    const int qc = (t == 0) ? 0 : (t == 1) ? 1 : (t == 2) ? 2 : (t == 3) ? 5 : (t == 4) ? 6 : (t == 5) ? 3 : (t == 6) ? 4 : 9;
                    const float bias2 = b_logit[h] * LOG2E; const bool longfirst = (j & 1) == 0;
                    sba::p_unit(b, h, ((step == 0) == longfirst) ? qa : qc, QB, KB, VT, G2, AO, bias2, lds + RING_OFF);
                } else for (int pu = vcu; pu < 256; pu += G) {
                    const int bh = pu >> 3, s = pu & 7, b = bh >> 4, h = bh & 15; const float bias2 = b_logit[h] * LOG2E; const bool longfirst = (pu & 1) == 0;
                    sba::p_unit(b, h, ((step == 0) == longfirst) ? 15 - s : s, QB, KB, VT, G2, AO, bias2, lds + RING_OFF);
                }
            }
        }
        if (BOTH(9)) GRID_BAR();
    }
    if (IN(11)) {
        unsigned* cmb = (unsigned*)(ctl + CW_CMB + 64 * args.li);
        { PHASE_IDS();
          const int half = G / 2; int ndone = 0;
          if (bx >= half) for (int pair = bx - half; pair < 128; pair += G - half) { sba::s_combine(pair, out, QB, G2, b_logit, PO, LT, AO); ++ndone; }
          if (ndone) { asm volatile("s_waitcnt vmcnt(0)" ::: "memory"); __syncthreads();
              if (tid == 0) { __builtin_amdgcn_fence(__ATOMIC_RELEASE, "agent"); asm volatile("s_waitcnt vmcnt(0)" ::: "memory"); (void)__hip_atomic_fetch_add(cmb, (unsigned)ndone, __ATOMIC_RELAXED, __HIP_MEMORY_SCOPE_AGENT); } } }
        pg8::Gemm g{DM, DM}; pg8::Order S; S.init(AO, W5T, DM, DM, 32, 8, DM, 8, 32, 0, G, bx);
        S.wait_cnt = cmb; S.wait_n = 128u;
        EpiOut E{OUTB, OUTS, DM};
        pg8::gemm_phase<EpiOut, pg8::Order, true, true>(lds + RING_OFF, g, S, E);
        if (BOTH(11)) GRID_BAR();
    }
    if (IN(12)) {
        PHASE_IDS();
        f32x4 gp[8]; load_row8(g_post + DM, lane, gp);
        for (int m = gw; m < MREAL; m += NGW) {
            f32x4 o[8], x[8]; load_row8_bf16(X1B + (size_t)m * DM, lane, x);
            if (m < MPROMPT) load_row8_bf16(OUTB + (size_t)m * DM, lane, o);
            else { load_row8(OUTS + (size_t)(m - MPROMPT) * DM, lane, o);
                for (int sp = 1; sp < 8; ++sp) { f32x4 t[8]; load_row8(OUTS + ((size_t)sp * 256 + (m - MPROMPT)) * DM, lane, t);
#pragma unroll
                    for (int j = 0; j < 8; ++j) o[j] += t[j]; } }
            const float rs = 1.0f / sqrtf(wave_sum(sumsq8(o)) * (1.0f / DM) + EPS);
            float* yo = (m < MPROMPT) ? out + O_YP + (size_t)m * DM : out + O_YS + (size_t)(m - MPROMPT) * DM;
#pragma unroll
            for (int j = 0; j < 8; ++j) ((f32x4*)yo)[64 * j + lane] = x[j] + o[j] * rs * gp[j];
        }
    }
#undef IN
#undef BOTH
#undef GRID_BAR
}

extern "C" void kernel_launch(void* const* d_in, const int* in_sizes, int n_in, void* d_out, int out_size, void* d_ws, size_t ws_size, hipStream_t stream) {
    static int grid = 0;
    if (grid == 0) {
        if (n_in != 24 || (size_t)out_size != O_END || ws_size < WS_END) { fprintf(stderr, "kernel_launch: unexpected shapes: n_in %d out %d ws %zu\n", n_in, out_size, ws_size); grid = -1; return; }
        int dev = 0, cus = 0, per_cu = 0;
        if (hipGetDevice(&dev) != hipSuccess || hipDeviceGetAttribute(&cus, hipDeviceAttributeMultiprocessorCount, dev) != hipSuccess) { grid = -1; return; }
        if (hipFuncSetAttribute((const void*)yoco_fwd, hipFuncAttributeMaxDynamicSharedMemorySize, LDS_BYTES) != hipSuccess) { fprintf(stderr, "kernel_launch: hipFuncSetAttribute failed\n"); grid = -1; return; }
        if (hipOccupancyMaxActiveBlocksPerMultiprocessor(&per_cu, (const void*)yoco_fwd, NWAVES * 64, LDS_BYTES) != hipSuccess || per_cu < 1)
            fprintf(stderr, "kernel_launch: occupancy query reports %d workgroups per CU\n", per_cu);
        (void)hipGetLastError();
        grid = cus;
    }
    if (grid < 0) return;
    if (hipMemsetAsync((char*)d_ws + WS_CTL, 0, CTL_ZERO_BYTES, stream) != hipSuccess) return;
    Args a{};
    for (int i = 0; i < 24; ++i) a.in[i] = (const float*)d_in[i];
    a.out = (float*)d_out; a.ws = (unsigned char*)d_ws;
    if (N_LAUNCHES == 1) { a.ph_lo = 0; a.ph_hi = NPHASE; a.li = 0; hipLaunchKernelGGL(yoco_fwd, dim3(grid), dim3(NWAVES * 64), LDS_BYTES, stream, a); }
    else for (int p = 0; p < NPHASE; ++p) { a.ph_lo = p; a.ph_hi = p + 1; a.li = p; hipLaunchKernelGGL(yoco_fwd, dim3(grid), dim3(NWAVES * 64), LDS_BYTES, stream, a); }
#ifdef PROBE_EXTRA
    { const int extra[] = {PROBE_EXTRA}; int li = 20;
      for (int pe : extra) { const int p = pe % 100; a.mode = pe / 100; a.ph_lo = p; a.ph_hi = p + 1; a.li = li++; hipLaunchKernelGGL(yoco_fwd, dim3(grid), dim3(NWAVES * 64), LDS_BYTES, stream, a); } }
#endif
}
```

```cpp
#include <hip/hip_runtime.h>
#include <cstdio>
#include <cstdint>

#ifndef MK_N_LAUNCHES
#define MK_N_LAUNCHES 1
#endif

namespace pg8 {
#define PG8_LAS __attribute__((address_space(3)))
typedef unsigned short bf16_t;
typedef short bf16x8 __attribute__((ext_vector_type(8)));
typedef float f32x4 __attribute__((ext_vector_type(4)));
typedef unsigned u32x4 __attribute__((ext_vector_type(4)));
typedef unsigned u32x2 __attribute__((ext_vector_type(2)));
constexpr int BM = 256, BK = 64, HALF = 128, HTB = HALF * BK * 2, STAGE_BYTES = 8 * HTB, NXCD = 8, WGM = 8;

__host__ __device__ __forceinline__ int lds_byte(int r, int c) { const int st = (r >> 4) * 2 + (c >> 5), rr = r & 15, cc = c & 31, ob = rr * 64 + cc * 2; return st * 1024 + (ob ^ (((ob >> 9) & 1) << 5)); }
__host__ __device__ __forceinline__ void stage_rc(int b, int& R, int& C) { const int st = b / 1024, sb = b % 1024, swz = sb ^ (((sb >> 9) & 1) << 5); R = (st >> 1) * 16 + swz / 64; C = (st & 1) * 32 + (swz % 64) / 2; }
__host__ __device__ __forceinline__ int perm32(int rho) { const int n = rho >> 4, i = rho & 15; return 8 * (i >> 2) + 4 * n + (i & 3); }

struct Unit { int pm, pn, nt, aux; const char* a; const char* b; };
struct Gemm { int lda, ldb; };

struct Order {
    int nMp, nN, nP, nS, G, c, ntP, ntS, pmS, ablk;
    const char* A; const char* B; size_t tstepA, tstepB, ksplit;
    bool sfirst = false;
    bool sig_wg = false;
    unsigned* sig = nullptr; int sig_lo = 0, sig_hi = 0;
    unsigned* wait_cnt = nullptr; unsigned wait_n = 0;
    __device__ void init(const bf16_t* A_, const bf16_t* B_, int lda, int ldb, int nMp_, int nN_, int K, int nsplit, int pmS_, int ablk_, int G_, int c_) {
        A = (const char*)A_; B = (const char*)B_; nMp = nMp_; nN = nN_; nP = nMp * nN; nS = nN * nsplit; G = G_; c = c_; ntP = K / BK; ntS = K / nsplit / BK; pmS = pmS_; ablk = ablk_;
        tstepA = (size_t)BM * lda * 2; tstepB = (size_t)BM * ldb * 2; ksplit = (size_t)(K / nsplit) * 2; }
    __device__ bool next(int i, Unit& u) const {
        const long L0 = (long)i * G + c; if (L0 >= nP + nS) return false;
        const long L = sfirst ? (L0 < nS ? nP + L0 : L0 - nS) : L0;
        if (L < nP) {
            int wgid = (int)L; { const int q = nP / NXCD, r = nP % NXCD, xcd = wgid % NXCD, off = wgid / NXCD; wgid = (xcd < r ? xcd * (q + 1) : r * (q + 1) + (xcd - r) * q) + off; }
            const int nig = WGM * nN, gid = wgid / nig, fm = gid * WGM, gsz = (nMp - fm) < WGM ? (nMp - fm) : WGM;
            u.pm = fm + ((wgid % nig) % gsz); u.pn = (wgid % nig) / gsz; u.nt = ntP; u.aux = 0;
            u.a = A + (size_t)u.pm * tstepA + (ablk ? (size_t)(u.pn >> 1) * 512 : (size_t)0); u.b = B + (size_t)u.pn * tstepB;
        } else {
            const int j = (int)L - nP; u.pn = j % nN; u.aux = j / nN; u.pm = pmS; u.nt = ntS;
            u.a = A + (size_t)pmS * tstepA + (size_t)u.aux * ksplit + (ablk ? (size_t)(u.pn >> 1) * 512 : (size_t)0); u.b = B + (size_t)u.pn * tstepB + (size_t)u.aux * ksplit;
        }
        return true;
    }
    __device__ __forceinline__ void a_ready(const Unit& u) const {
        if (wait_cnt && u.pm == pmS) {
            for (unsigned sp = 0; __hip_atomic_load(wait_cnt, __ATOMIC_RELAXED, __HIP_MEMORY_SCOPE_AGENT) < wait_n && sp < (1u << 20); ++sp) __builtin_amdgcn_s_sleep(2);
            __builtin_amdgcn_fence(__ATOMIC_ACQUIRE, "agent");
            asm volatile("s_waitcnt vmcnt(0)" ::: "memory");
        } }
    __device__ __forceinline__ void done(const Unit& u) const {
        if (sig && sig_wg && u.pm == pmS && u.pn >= sig_lo && u.pn < sig_hi) {
            asm volatile("s_waitcnt vmcnt(0)" ::: "memory"); __syncthreads();
            if (threadIdx.x == 0) { __builtin_amdgcn_fence(__ATOMIC_RELEASE, "agent"); asm volatile("s_waitcnt vmcnt(0)" ::: "memory"); (void)__hip_atomic_fetch_add(sig, 1u, __ATOMIC_RELAXED, __HIP_MEMORY_SCOPE_AGENT); }
        } else if (sig && u.pm == pmS && u.pn >= sig_lo && u.pn < sig_hi) {
            asm volatile("s_waitcnt vmcnt(0)" ::: "memory");
            if ((threadIdx.x & 63) == 0) { __builtin_amdgcn_fence(__ATOMIC_RELEASE, "agent"); asm volatile("s_waitcnt vmcnt(0)" ::: "memory"); (void)__hip_atomic_fetch_add(sig, 1u, __ATOMIC_RELAXED, __HIP_MEMORY_SCOPE_AGENT); } } }
};

__device__ __forceinline__ unsigned cvt_pk_bf16(float lo, float hi) { unsigned r; asm volatile("v_cvt_pk_bf16_f32 %0, %1, %2" : "=v"(r) : "v"(lo), "v"(hi)); return r; }

template <class Epi, class Sched, bool ALIGN_EPI = false, bool SP2 = false>
__device__ __forceinline__ void gemm_phase(PG8_LAS unsigned char* lds, const Gemm g, const Sched& S, const Epi& E) {
    int tid_ = threadIdx.x; asm volatile("" : "+v"(tid_));
    const int tid = tid_, wid = __builtin_amdgcn_readfirstlane(tid >> 6), lane = tid & 63, wr = wid >> 2, wc = wid & 3, fr = lane & 15, fq = lane >> 4;
    unsigned voffA[2], voffB[2];
#pragma unroll
    for (int i = 0; i < 2; ++i) { int R, C; stage_rc(tid * 16 + i * 8192, R, C); const int Rb = Epi::PERM ? ((R & ~31) + perm32(R & 31)) : R;
        const int Ra = Epi::PERMA ? ((R & ~63) + 4 * (R & 15) + ((R >> 4) & 3)) : R;
        voffA[i] = (unsigned)(Ra * g.lda + C) * 2u; voffB[i] = (unsigned)(Rb * g.ldb + C) * 2u; }
    const size_t kstep = (size_t)(BK * 2);
    const size_t hstepA = (size_t)HALF * g.lda * 2, hstepB = (size_t)HALF * g.ldb * 2;
    const unsigned ldsw = (unsigned)wid * 1024u;
    const int aoff = lds_byte(wr * 64 + fr, fq * 8), boff = lds_byte(wc * 32 + fr, fq * 8);
#define PG8_SA(b, h) (((b) * 2 + (h)) * HTB)
#define PG8_SB(b, h) ((4 + (b) * 2 + (h)) * HTB)
#define PG8_STAGE(bufoff, gbase, voff) do { _Pragma("unroll") for (int _i = 0; _i < 2; ++_i) \
        __builtin_amdgcn_global_load_lds((const unsigned*)((const char*)(gbase) + (voff)[_i]), (PG8_LAS unsigned*)(lds + (bufoff) + ldsw + _i * 8192), 16, 0, 0); } while (0)
#define PG8_LDA(dst, b, h) do { _Pragma("unroll") for (int m = 0; m < 4; ++m) _Pragma("unroll") for (int k = 0; k < 2; ++k) dst[m][k] = *(const PG8_LAS bf16x8*)(lds + PG8_SA(b, h) + aoff + m * 2048 + k * 1024); } while (0)
#define PG8_LDB(dst, b, h) do { _Pragma("unroll") for (int n = 0; n < 2; ++n) _Pragma("unroll") for (int k = 0; k < 2; ++k) dst[n][k] = *(const PG8_LAS bf16x8*)(lds + PG8_SB(b, h) + boff + n * 2048 + k * 1024); } while (0)
#define PG8_MMA(ai, bj, At, Bt) do { __builtin_amdgcn_s_setprio(1); _Pragma("unroll") for (int m = 0; m < 4; ++m) _Pragma("unroll") for (int n = 0; n < 2; ++n) _Pragma("unroll") for (int k = 0; k < 2; ++k) \
        acc[ai][bj][m][n] = __builtin_amdgcn_mfma_f32_16x16x32_bf16(Bt[n][k], At[m][k], acc[ai][bj][m][n], 0, 0, 0); __builtin_amdgcn_s_setprio(0); } while (0)
#define PG8_WAIT_V(n) asm volatile("s_waitcnt vmcnt(" #n ")" ::: "memory")
#define PG8_WAIT_L(n) asm volatile("s_waitcnt lgkmcnt(" #n ")" ::: "memory")
#define PG8_BAR __builtin_amdgcn_s_barrier()
#define PG8_SCHED __builtin_amdgcn_sched_barrier(0)
    Unit cur, nxt; int ui = 0;
    if (!S.next(0, cur)) return;
    f32x4 acc[2][2][4][2];
#pragma unroll
    for (int a = 0; a < 2; ++a)
#pragma unroll
        for (int b = 0; b < 2; ++b)
#pragma unroll
            for (int m = 0; m < 4; ++m)
#pragma unroll
                for (int n = 0; n < 2; ++n) acc[a][b][m][n] = (f32x4){0.f, 0.f, 0.f, 0.f};
    bf16x8 At[4][2], B0[2][2], B1[2][2];
    const char* cA = cur.a; const char* cB = cur.b;
    S.a_ready(cur);
    if constexpr (SP2) {
        PG8_STAGE(PG8_SB(0, 0), cB, voffB); PG8_STAGE(PG8_SB(0, 1), cB + hstepB, voffB); PG8_STAGE(PG8_SA(0, 0), cA, voffA); PG8_STAGE(PG8_SA(0, 1), cA + hstepA, voffA);
        if (wr == 1) PG8_BAR;
        PG8_WAIT_V(2); PG8_BAR;
        PG8_STAGE(PG8_SB(1, 0), cB + kstep, voffB); PG8_STAGE(PG8_SA(1, 0), cA + kstep, voffA); PG8_STAGE(PG8_SB(1, 1), cB + hstepB + kstep, voffB);
        PG8_WAIT_V(6); PG8_BAR;
    } else {
        PG8_STAGE(PG8_SB(0, 0), cB, voffB); PG8_STAGE(PG8_SA(0, 0), cA, voffA); PG8_STAGE(PG8_SB(0, 1), cB + hstepB, voffB); PG8_STAGE(PG8_SA(0, 1), cA + hstepA, voffA);
        if (wr == 1) PG8_BAR;
        PG8_WAIT_V(4); PG8_BAR;
        PG8_STAGE(PG8_SB(1, 0), cB + kstep, voffB); PG8_STAGE(PG8_SA(1, 0), cA + kstep, voffA); PG8_STAGE(PG8_SB(1, 1), cB + hstepB + kstep, voffB);
        PG8_WAIT_V(6); PG8_BAR;
    }
    for (;;) {
        const bool has_next = S.next(ui + 1, nxt);
        const char* nA = has_next ? nxt.a : cA; const char* nB = has_next ? nxt.b : cB;
        const int nt = cur.nt;
        for (int t = 0; t < nt; t += 2) {
            const bool last = (t == nt - 2);
            const char* a1 = cA + (size_t)(t + 1) * kstep;
            const char* a2 = last ? nA : cA + (size_t)(t + 2) * kstep; const char* b2 = last ? nB : cB + (size_t)(t + 2) * kstep;
            const char* a3 = a2 + kstep; const char* b3 = b2 + kstep;
            if (last && has_next) S.a_ready(nxt);
            if constexpr (SP2) {
            PG8_LDB(B0, 0, 0); PG8_LDB(B1, 0, 1); PG8_SCHED; PG8_LDA(At, 0, 0); PG8_STAGE(PG8_SA(1, 1), a1 + hstepA, voffA);
            PG8_WAIT_V(8); PG8_WAIT_L(0); PG8_BAR; PG8_MMA(0, 0, At, B0); PG8_MMA(0, 1, At, B1); PG8_BAR; PG8_SCHED;
            PG8_LDA(At, 0, 1); PG8_STAGE(PG8_SB(0, 0), b2, voffB); PG8_STAGE(PG8_SB(0, 1), b2 + hstepB, voffB); PG8_STAGE(PG8_SA(0, 0), a2, voffA);
            PG8_WAIT_V(8); PG8_WAIT_L(0); PG8_BAR; PG8_MMA(1, 0, At, B0); PG8_MMA(1, 1, At, B1); PG8_BAR; PG8_SCHED;
            PG8_LDB(B0, 1, 0); PG8_LDB(B1, 1, 1); PG8_SCHED; PG8_LDA(At, 1, 0); PG8_STAGE(PG8_SA(0, 1), a2 + hstepA, voffA);
            PG8_WAIT_V(8); PG8_WAIT_L(0); PG8_BAR; PG8_MMA(0, 0, At, B0); PG8_MMA(0, 1, At, B1); PG8_BAR; PG8_SCHED;
            PG8_LDA(At, 1, 1); PG8_STAGE(PG8_SB(1, 0), b3, voffB); PG8_STAGE(PG8_SB(1, 1), b3 + hstepB, voffB); PG8_STAGE(PG8_SA(1, 0), a3, voffA);
            PG8_WAIT_V(8); PG8_WAIT_L(0); PG8_BAR; PG8_MMA(1, 0, At, B0); PG8_MMA(1, 1, At, B1); PG8_BAR; PG8_SCHED;
            } else {
            PG8_LDB(B0, 0, 0); PG8_SCHED; PG8_LDA(At, 0, 0); PG8_STAGE(PG8_SA(1, 1), a1 + hstepA, voffA);
            PG8_WAIT_L(8); PG8_BAR; PG8_WAIT_L(0); PG8_MMA(0, 0, At, B0); PG8_BAR; PG8_SCHED;
            PG8_LDB(B1, 0, 1); PG8_STAGE(PG8_SB(0, 0), b2, voffB);
            PG8_BAR; PG8_WAIT_L(0); PG8_MMA(0, 1, At, B1); PG8_BAR;
            PG8_LDA(At, 0, 1); PG8_STAGE(PG8_SA(0, 0), a2, voffA);
            PG8_BAR; PG8_WAIT_L(0); PG8_MMA(1, 0, At, B0); PG8_BAR; PG8_SCHED;
            PG8_STAGE(PG8_SB(0, 1), b2 + hstepB, voffB);
            PG8_WAIT_V(6); PG8_BAR; PG8_MMA(1, 1, At, B1); PG8_BAR;
            PG8_LDB(B0, 1, 0); PG8_SCHED; PG8_LDA(At, 1, 0); PG8_STAGE(PG8_SA(0, 1), a2 + hstepA, voffA);
            PG8_WAIT_L(8); PG8_BAR; PG8_WAIT_L(0); PG8_MMA(0, 0, At, B0); PG8_BAR; PG8_SCHED;
            PG8_LDB(B1, 1, 1); PG8_STAGE(PG8_SB(1, 0), b3, voffB);
            PG8_BAR; PG8_WAIT_L(0); PG8_MMA(0, 1, At, B1); PG8_BAR;
            PG8_LDA(At, 1, 1); PG8_STAGE(PG8_SA(1, 0), a3, voffA);
            PG8_BAR; PG8_WAIT_L(0); PG8_MMA(1, 0, At, B0); PG8_BAR; PG8_SCHED;
            PG8_STAGE(PG8_SB(1, 1), b3 + hstepB, voffB);
            PG8_WAIT_V(6); PG8_BAR; PG8_MMA(1, 1, At, B1); PG8_BAR;
            }
        }
        if constexpr (ALIGN_EPI) { if (wr == 0) PG8_BAR; }
        E(acc, cur, wr, wc, fr, fq); S.done(cur);
        if (!has_next) break;
#pragma unroll
        for (int a = 0; a < 2; ++a)
#pragma unroll
            for (int b = 0; b < 2; ++b)
#pragma unroll
                for (int m = 0; m < 4; ++m)
#pragma unroll
                    for (int n = 0; n < 2; ++n) acc[a][b][m][n] = (f32x4){0.f, 0.f, 0.f, 0.f};
        cur = nxt; cA = nA; cB = nB; ++ui;
        if constexpr (ALIGN_EPI) { if (wr == 1) PG8_BAR; }
    }
    PG8_WAIT_V(0);
    if constexpr (!ALIGN_EPI) { if (wr == 0) PG8_BAR; }
    PG8_BAR;
#undef PG8_SA
#undef PG8_SB
#undef PG8_STAGE
#undef PG8_LDA
#undef PG8_LDB
#undef PG8_MMA
#undef PG8_WAIT_V
#undef PG8_WAIT_L
#undef PG8_BAR
#undef PG8_SCHED
}
}

constexpr int NWAVES = 8;
constexpr int N_LAUNCHES = MK_N_LAUNCHES;
constexpr int NPHASE = 13;
constexpr int DM = 2048, SEQ = 4096, MPROMPT = 8192, MSAMP = 128, MREAL = 8320, MPAD = 8448;
constexpr int DR = 2560;
constexpr int HD = 128, KVW = 512;
constexpr int NPG = 64;
constexpr float EPS = 1e-6f;
constexpr float LOG2E = 1.4426950408889634f;
constexpr float QSCALE = 1.4426950408889634f / 11.313708498984761f;
constexpr float MASKV = -1.0e30f;
constexpr size_t O_YP = 0, O_YS = 16777216, O_CVP = 17039360, O_HP = 17054720, O_KP = 17059840, O_VP = 21254144, O_CVS = 25448448, O_HS = 25694208, O_KS = 25776128, O_VS = 25841664, O_END = 25907200;
constexpr size_t MiB = 1u << 20;
#if defined(PROBE_EXTRA) || MK_N_LAUNCHES != 1
constexpr int CW_PAN = 200000;
constexpr size_t WS_CTL = 0, CTL_ZERO_BYTES = 1 * MiB;
#else
constexpr int CW_PAN = 8192;
constexpr size_t WS_CTL = 0, CTL_ZERO_BYTES = (size_t)(8192 + 1024) * 4;
#endif
constexpr size_t WS_W1T = 2 * MiB, WS_WGT = 22 * MiB, WS_W3T = 25 * MiB, WS_W4T = 35 * MiB, WS_W5T = 55 * MiB;
constexpr size_t WS_CL = 63 * MiB, WS_SA = 64 * MiB, WS_SB = 65 * MiB, WS_LT = 66 * MiB, WS_PO = 67 * MiB;
constexpr size_t WS_XN = 84 * MiB, WS_XR = 117 * MiB, WS_GT = 159 * MiB, WS_XC = 201 * MiB, WS_Y = 243 * MiB;
constexpr size_t WS_AL = 285 * MiB, WS_BB = 368 * MiB, WS_OUT = 451 * MiB, WS_X1 = 517 * MiB;
constexpr size_t WS_KB = 583 * MiB, WS_VT = 592 * MiB, WS_QB = 600 * MiB, WS_G2 = 633 * MiB, WS_AO = 666 * MiB, WS_OUTS = 700 * MiB, WS_XB = 724 * MiB, WS_SQ2 = 726 * MiB, WS_END = 728 * MiB;
constexpr int CW_BAR = 4096;
constexpr int CW_SGA = 3584, CW_SGB = 3840;
constexpr int CW_SIG = 2048;
constexpr int CW_CMB = 1024;
constexpr int RING_OFF = 0, RING_BYTES = 131072;
constexpr int LDSCTL_OFF = RING_BYTES, MISC_OFF = LDSCTL_OFF + 320;
constexpr int LDS_BYTES = 147456;

#define GAS __attribute__((address_space(1)))
#define LAS __attribute__((address_space(3)))
typedef unsigned short bf16;
typedef unsigned v4u __attribute__((ext_vector_type(4)));
typedef unsigned v2u __attribute__((ext_vector_type(2)));
typedef float f32x4 __attribute__((ext_vector_type(4)));
typedef float f32x16 __attribute__((ext_vector_type(16)));
typedef short bf16x8 __attribute__((ext_vector_type(8)));
typedef short s16x4 __attribute__((ext_vector_type(4)));
typedef GAS unsigned gu32;
#define RLX_AGENT __ATOMIC_RELAXED, __HIP_MEMORY_SCOPE_AGENT
#define LDS_WAIT() asm volatile("s_waitcnt lgkmcnt(0)" ::: "memory")
__device__ __forceinline__ unsigned f2bf(float f) { unsigned u = __builtin_bit_cast(unsigned, f); return (u + 0x7fffu + ((u >> 16) & 1u)) >> 16; }
typedef float f32x2_t __attribute__((ext_vector_type(2))); typedef __bf16 bf16x2_t __attribute__((ext_vector_type(2)));
__device__ __forceinline__ unsigned pk2(float lo, float hi) { f32x2_t v = {lo, hi}; bf16x2_t b = __builtin_convertvector(v, bf16x2_t); return __builtin_bit_cast(unsigned, b); }
__device__ __forceinline__ float bf2f(unsigned short b) { return __builtin_bit_cast(float, (unsigned)b << 16); }
__device__ __forceinline__ float bflo(unsigned w) { return __builtin_bit_cast(float, w << 16); }
__device__ __forceinline__ float bfhi(unsigned w) { return __builtin_bit_cast(float, w & 0xffff0000u); }
__device__ __forceinline__ float ex2(float x) { return __builtin_amdgcn_exp2f(x); }
__device__ __forceinline__ float lg2(float x) { return __builtin_amdgcn_logf(x); }
__device__ __forceinline__ float sigmoid_f(float x) { return __builtin_amdgcn_rcpf(1.f + ex2(-LOG2E * x)); }
__device__ __forceinline__ float silu_f(float x) { return x * sigmoid_f(x); }

#define XB_TMO      128
#define XB_XCNT(j)  (256  + 64 * (j))
#define XB_XSUB(j)  (1280 + 64 * (j))
#define XB_XGEN(j)  (2304 + 64 * (j))
#define XB_TOP      3328
#define XB_TOPGEN   3392
#define XCD_BAR_WORDS 3456
#define XB_SPIN_CAP (1u << 18)
__device__ __forceinline__ unsigned xb_ld(unsigned* p)              { return __hip_atomic_load(p, __ATOMIC_RELAXED, __HIP_MEMORY_SCOPE_AGENT); }
__device__ __forceinline__ unsigned xb_add(unsigned* p, unsigned v) { return __hip_atomic_fetch_add(p, v, __ATOMIC_RELAXED, __HIP_MEMORY_SCOPE_AGENT); }
__device__ __forceinline__ unsigned xb_xcc_id() { return (unsigned)__builtin_amdgcn_s_getreg((3 << 11) | 20) & 0xFu; }
#define XB_SPIN(cond, bar) do { unsigned _sp = 0; while (cond) { __builtin_amdgcn_s_sleep(1); \
    if ((++_sp & 255u) == 0u) { if (xb_ld(&(bar)[XB_TMO])) break; if (_sp > XB_SPIN_CAP) { atomicAdd(&(bar)[XB_TMO], 1u); break; } } } } while (0)
struct XcdBarrier { unsigned* bar; unsigned x; volatile LAS unsigned* st; };
__device__ __forceinline__ XcdBarrier xcd_barrier_post(unsigned* bar, volatile LAS unsigned* st) {
    XcdBarrier b; b.bar = bar; b.x = xb_xcc_id(); b.st = st;
    if (threadIdx.x == 0) (void)xb_add(&bar[XB_XCNT(b.x)], 1u);
    return b;
}
__device__ __forceinline__ void xcd_barrier_complete(unsigned* bar, unsigned x, unsigned& nloc, unsigned& nx) {
    const unsigned G = gridDim.x * gridDim.y * gridDim.z;
    unsigned sum, cnt, mine, sp = 0u;
    for (;;) {
        sum = 0u; cnt = 0u; mine = 0u;
#pragma unroll
        for (unsigned j = 0; j < 16; ++j) { const unsigned c = xb_ld(&bar[XB_XCNT(j)]); sum += c; cnt += (c > 0u) ? 1u : 0u; mine = (j == x) ? c : mine; }
        if (sum == G) break;
        __builtin_amdgcn_s_sleep(1);
        if ((++sp & 255u) == 0u) { if (xb_ld(&bar[XB_TMO])) break; if (sp > XB_SPIN_CAP) { atomicAdd(&bar[XB_TMO], 1u); break; } }
    }
    nloc = mine > 0u ? mine : 1u; nx = cnt > 0u ? cnt : 1u;
}
__device__ __forceinline__ void xcd_barrier(const XcdBarrier& b) {
    asm volatile("s_waitcnt vmcnt(0)" ::: "memory");
    __syncthreads();
    if (threadIdx.x == 0) {
        unsigned* bar = b.bar;
        __builtin_amdgcn_s_waitcnt(0);
        unsigned nloc = b.st[0], nx = b.st[1];
        if (nloc == 0u) { xcd_barrier_complete(bar, b.x, nloc, nx); b.st[0] = nloc; b.st[1] = nx; }
        const unsigned old = xb_add(&bar[XB_XSUB(b.x)], 1u);
        const unsigned gen = old / nloc;
        if (old + 1u == (gen + 1u) * nloc) {
            __builtin_amdgcn_fence(__ATOMIC_RELEASE, "agent");
            asm volatile("s_waitcnt vmcnt(0)" ::: "memory");
            const unsigned og = xb_add(&bar[XB_TOP], 1u);
            const unsigned tg = og / nx;
            if (og + 1u == (tg + 1u) * nx) xb_add(&bar[XB_TOPGEN], 1u);
            else XB_SPIN(xb_ld(&bar[XB_TOPGEN]) == tg, bar);
            __builtin_amdgcn_fence(__ATOMIC_ACQUIRE, "agent");
            xb_add(&bar[XB_XGEN(b.x)], 1u);
            asm volatile("s_waitcnt vmcnt(0)" ::: "memory");
        } else {
            XB_SPIN(xb_ld(&bar[XB_XGEN(b.x)]) == gen, bar);
            __builtin_amdgcn_fence(__ATOMIC_ACQUIRE, "agent");
            asm volatile("s_waitcnt vmcnt(0)" ::: "memory");
        }
    }
    __syncthreads();
}

using pg8::Unit;
struct EpiG1 {
    static constexpr bool PERM = true, AFTER_DRAIN = false, PERMA = false;
    bf16* XR; bf16* GT;
    __device__ __forceinline__ void operator()(const f32x4 (&acc)[2][2][4][2], const Unit& u, int wr, int wc, int fr, int fq) const {
        const bool gate = u.pn >= 10; bf16* base = gate ? GT : XR; const int colt = (gate ? u.pn - 10 : u.pn) * 256;
        const int row0 = u.pm * 256 + wr * 64 + fr, col0 = colt + wc * 32 + 8 * fq;
#pragma unroll
        for (int ai = 0; ai < 2; ++ai)
#pragma unroll
            for (int m = 0; m < 4; ++m) { bf16* rowp = base + (size_t)(row0 + ai * 128 + m * 16) * DR + col0;
#pragma unroll
                for (int bj = 0; bj < 2; ++bj) { f32x4 v0 = acc[ai][bj][m][0], v1 = acc[ai][bj][m][1];
                    if (gate) {
#pragma unroll
                        for (int j = 0; j < 4; ++j) { v0[j] = silu_f(v0[j]); v1[j] = silu_f(v1[j]); } }
                    v4u w; w.x = pk2(v0[0], v0[1]); w.y = pk2(v0[2], v0[3]); w.z = pk2(v1[0], v1[1]); w.w = pk2(v1[2], v1[3]);
                    *(v4u*)(rowp + bj * 128) = w; } }
    }
};
struct EpiF32 {
    static constexpr bool PERM = false, AFTER_DRAIN = false, PERMA = false;
    float* O; float* OS; int ldc;
    __device__ __forceinline__ void operator()(const f32x4 (&acc)[2][2][4][2], const Unit& u, int wr, int wc, int fr, int fq) const {
        float* base = (u.pm == 32) ? OS + (size_t)u.aux * 256 * ldc : O + (size_t)u.pm * 256 * ldc;
        const int row0 = wr * 64 + fr, col0 = u.pn * 256 + wc * 32 + 4 * fq;
#pragma unroll
        for (int ai = 0; ai < 2; ++ai)
#pragma unroll
            for (int m = 0; m < 4; ++m) { float* rowp = base + (size_t)(row0 + ai * 128 + m * 16) * ldc + col0;
#pragma unroll
                for (int bj = 0; bj < 2; ++bj)
#pragma unroll
                    for (int n = 0; n < 2; ++n) *(f32x4*)(rowp + bj * 128 + n * 16) = acc[ai][bj][m][n]; }
    }
};
struct EpiOut {
    static constexpr bool PERM = true, AFTER_DRAIN = false, PERMA = false;
    bf16* OB; float* OS; int ldc;
    __device__ __forceinline__ void operator()(const f32x4 (&acc)[2][2][4][2], const Unit& u, int wr, int wc, int fr, int fq) const {
        const int row0 = wr * 64 + fr, col0 = u.pn * 256 + wc * 32 + 8 * fq;
        if (u.pm == 32) { float* base = OS + (size_t)u.aux * 256 * ldc;
#pragma unroll
            for (int ai = 0; ai < 2; ++ai)
#pragma unroll
                for (int m = 0; m < 4; ++m) { float* rowp = base + (size_t)(row0 + ai * 128 + m * 16) * ldc + col0;
#pragma unroll
                    for (int bj = 0; bj < 2; ++bj) { *(f32x4*)(rowp + bj * 128) = acc[ai][bj][m][0]; *(f32x4*)(rowp + bj * 128 + 4) = acc[ai][bj][m][1]; } }
        } else { bf16* base = OB + (size_t)u.pm * 256 * ldc;
#pragma unroll
            for (int ai = 0; ai < 2; ++ai)
#pragma unroll
                for (int m = 0; m < 4; ++m) { bf16* rowp = base + (size_t)(row0 + ai * 128 + m * 16) * ldc + col0;
#pragma unroll
                    for (int bj = 0; bj < 2; ++bj) { const f32x4 v0 = acc[ai][bj][m][0], v1 = acc[ai][bj][m][1];
                        v4u w; w.x = pk2(v0[0], v0[1]); w.y = pk2(v0[2], v0[3]); w.z = pk2(v1[0], v1[1]); w.w = pk2(v1[2], v1[3]); *(v4u*)(rowp + bj * 128) = w; } }
        }
    }
};
__device__ __forceinline__ float dpp_shr(float old, float x, int sh) {
    const int o = __builtin_bit_cast(int, old), v = __builtin_bit_cast(int, x); int r;
    switch (sh) { case 1: r = __builtin_amdgcn_update_dpp(o, v, 0x111, 0xf, 0xf, false); break; case 2: r = __builtin_amdgcn_update_dpp(o, v, 0x112, 0xf, 0xf, false); break;
                  case 4: r = __builtin_amdgcn_update_dpp(o, v, 0x114, 0xf, 0xf, false); break; default: r = __builtin_amdgcn_update_dpp(o, v, 0x118, 0xf, 0xf, false); break; }
    return __builtin_bit_cast(float, r); }
struct EpiLru {
    static constexpr bool PERM = false, AFTER_DRAIN = false, PERMA = true;
    const bf16* XC; unsigned* AB; const float* b_r; const float* b_i; const float* cl; float* SA; float* SB; LAS float* xch;
    __device__ __forceinline__ void operator()(const f32x4 (&acc)[2][2][4][2], const Unit& u, int wr, int wc, int fr, int fq) const {
        const int chl = wc * 32 + 4 * fq, chb = u.pn * 128 + chl, trow = u.pm * 256 + wr * 64 + 4 * fr;
#pragma unroll
        for (int ai = 0; ai < 2; ++ai)
#pragma unroll
            for (int n = 0; n < 2; ++n) {
                const f32x4 br = *(const f32x4*)(b_r + chb + 16 * n), bi = *(const f32x4*)(b_i + chb + 16 * n), c4 = *(const f32x4*)(cl + chb + 16 * n);
                float As[4] = {1.f, 1.f, 1.f, 1.f}, Bs[4] = {0.f, 0.f, 0.f, 0.f};
#pragma unroll
                for (int m = 0; m < 4; ++m) { const size_t ro = (size_t)(trow + ai * 128 + m) * DR + chb + 16 * n;
                    const v2u xw = *(const v2u*)(XC + ro);
                    const float xc[4] = {bflo(xw.x), bfhi(xw.x), bflo(xw.y), bfhi(xw.y)};
                    const f32x4 ar = acc[ai][0][m][n] + br, ig = acc[ai][1][m][n] + bi;
                    v4u w;
#pragma unroll
                    for (int j = 0; j < 4; ++j) { const float r = sigmoid_f(ar[j]), ii = sigmoid_f(ig[j]); const float la = r * c4[j], a = ex2(la); const float om = __builtin_fmaf(-a, a, 1.0f);
                        const float bb = __builtin_amdgcn_sqrtf(__builtin_fmaxf(om, 0.f)) * ii * xc[j];
                        w[j] = pk2(la, bb);
                        Bs[j] = a * Bs[j] + bb; As[j] *= a; }
                    *(v4u*)(AB + ro) = w; }
#pragma unroll
                for (int j = 0; j < 4; ++j)
#pragma unroll
                    for (int sh = 1; sh < 16; sh <<= 1) { const float Al = dpp_shr(1.0f, As[j], sh), Bl = dpp_shr(0.0f, Bs[j], sh); Bs[j] = Bl * As[j] + Bs[j]; As[j] = Al * As[j]; }
                if (fr == 15) {
#pragma unroll
                    for (int j = 0; j < 4; ++j) { LAS float* p = xch + ((ai * 2 + wr) * 128 + chl + 16 * n + j) * 2; p[0] = As[j]; p[1] = Bs[j]; } }
            }
        asm volatile("s_waitcnt lgkmcnt(0)" ::: "memory"); __builtin_amdgcn_s_barrier(); asm volatile("" ::: "memory");
        const int t = (wr * 4 + wc) * 64 + fq * 16 + fr;
        if (t < 256 && u.pm < 32) { const int ai = t >> 7, c = t & 127; const LAS float* p0 = xch + ((ai * 2 + 0) * 128 + c) * 2; const LAS float* p1 = xch + ((ai * 2 + 1) * 128 + c) * 2;
            const float A0 = p0[0], B0 = p0[1], A1 = p1[0], B1 = p1[1];
            const size_t so = (size_t)((u.pm >> 4) * 32 + (u.pm & 15) * 2 + ai) * DR + u.pn * 128 + c;
            SA[so] = A0 * A1; SB[so] = B0 * A1 + B1; }
    }
};

template <int LAYER>
struct EpiNorm {
    static constexpr bool PERM = true, AFTER_DRAIN = false, PERMA = false;
    unsigned char* ws; const float* xf; float* yo; const float* gain; int li; LAS float* tab;
    __device__ __forceinline__ void operator()(const f32x4 (&acc)[2][2][4][2], const Unit& u, int wr, int wc, int fr_, int fq) const {
        int fr = fr_; asm volatile("" : "+v"(fr));
        const int row0 = wr * 64 + fr, col0 = u.pn * 256 + wc * 32 + 8 * fq; constexpr int ldc = DM;
        bf16* x1b = (bf16*)(ws + WS_X1); float* sq2 = (float*)(ws + WS_SQ2); float* OS = (float*)(ws + WS_OUTS); float* xb = (float*)(ws + WS_XB) + (size_t)LAYER * 65536;
        unsigned* cnt = (unsigned*)(ws + WS_CTL) + CW_PAN + (li * 2 + LAYER) * 512;
        if (u.pm == 32) { float* base = OS + (size_t)u.aux * 256 * ldc;
#pragma unroll
            for (int ai = 0; ai < 2; ++ai)
#pragma unroll
                for (int m = 0; m < 4; ++m) { float* rowp = base + (size_t)(row0 + ai * 128 + m * 16) * ldc + col0;
#pragma unroll
                    for (int bj = 0; bj < 2; ++bj) { *(f32x4*)(rowp + bj * 128) = acc[ai][bj][m][0]; *(f32x4*)(rowp + bj * 128 + 4) = acc[ai][bj][m][1]; } }
            return; }
        const int lane = fq * 16 + fr, wid = wr * 4 + wc;
        LAS float* P = tab; LAS float* Sr = tab + 2048;
#pragma unroll
        for (int ai = 0; ai < 2; ++ai)
#pragma unroll
            for (int m = 0; m < 4; ++m) { float q = 0.f;
#pragma unroll
                for (int bj = 0; bj < 2; ++bj)
#pragma unroll
                    for (int n = 0; n < 2; ++n) { const f32x4 v = acc[ai][bj][m][n]; q += (v[0] * v[0] + v[1] * v[1]) + (v[2] * v[2] + v[3] * v[3]); }
                q += __shfl_xor(q, 16); q += __shfl_xor(q, 32);
                if (fq == 0) P[(ai * 128 + row0 + m * 16) * 8 + wc] = q; }
        asm volatile("s_waitcnt lgkmcnt(0)" ::: "memory"); __builtin_amdgcn_s_barrier(); asm volatile("" ::: "memory");
        const int prow = wid * 32 + (lane & 31);
        if (lane < 32) { const float t = (P[prow * 8] + P[prow * 8 + 1]) + (P[prow * 8 + 2] + P[prow * 8 + 3]);
            __hip_atomic_store(xb + ((size_t)(u.pm * 256 + prow) * 8 + u.pn), t, __ATOMIC_RELAXED, __HIP_MEMORY_SCOPE_AGENT); }
        asm volatile("s_waitcnt vmcnt(0)" ::: "memory");
        if (lane == 0) (void)__hip_atomic_fetch_add(cnt + 16 * u.pm, 1u, __ATOMIC_RELAXED, __HIP_MEMORY_SCOPE_AGENT);
        if (wid == 0) { for (unsigned sp = 0; __hip_atomic_load(cnt + 16 * u.pm, __ATOMIC_RELAXED, __HIP_MEMORY_SCOPE_AGENT) < 64u && sp < (1u << 20); ++sp) __builtin_amdgcn_s_sleep(2);
            __builtin_amdgcn_fence(__ATOMIC_ACQUIRE, "agent"); }
        asm volatile("s_waitcnt vmcnt(0) lgkmcnt(0)" ::: "memory"); __builtin_amdgcn_s_barrier(); asm volatile("" ::: "memory");
        if (lane < 32) { const float* sl = xb + (size_t)(u.pm * 256 + prow) * 8; float t = 0.f;
#pragma unroll
            for (int k = 0; k < 8; ++k) t += __hip_atomic_load(sl + k, __ATOMIC_RELAXED, __HIP_MEMORY_SCOPE_AGENT);
            Sr[prow] = 1.0f / sqrtf(t * (1.0f / DM) + EPS); }
        asm volatile("s_waitcnt lgkmcnt(0)" ::: "memory"); __builtin_amdgcn_s_barrier(); asm volatile("" ::: "memory");
#pragma unroll
        for (int bj = 0; bj < 2; ++bj) { const f32x4 g0 = *(const f32x4*)(gain + col0 + bj * 128), g1 = *(const f32x4*)(gain + col0 + bj * 128 + 4);
#pragma unroll
            for (int ai = 0; ai < 2; ++ai) {
                f32x4 rx0[4], rx1[4]; v4u rxb[4];
#pragma unroll
                for (int m = 0; m < 4; ++m) { const size_t off = (size_t)(u.pm * 256 + ai * 128 + row0 + m * 16) * DM + col0 + bj * 128;
                    if (LAYER == 0) { rx0[m] = *(const f32x4*)(xf + off); rx1[m] = *(const f32x4*)(xf + off + 4); } else rxb[m] = *(const v4u*)(x1b + off); }
#pragma unroll
                for (int m = 0; m < 4; ++m) { const int r = ai * 128 + row0 + m * 16; const float rs = Sr[r]; const size_t off = (size_t)(u.pm * 256 + r) * DM + col0 + bj * 128;
                    const f32x4 a0 = acc[ai][bj][m][0] * rs * g0, a1 = acc[ai][bj][m][1] * rs * g1;
                    if (LAYER == 0) { const f32x4 x0 = rx0[m] + a0, x1 = rx1[m] + a1;
                        v4u w; w.x = pk2(x0[0], x0[1]); w.y = pk2(x0[2], x0[3]); w.z = pk2(x1[0], x1[1]); w.w = pk2(x1[2], x1[3]); *(v4u*)(x1b + off) = w;
                        float q = (x0[0] * x0[0] + x0[1] * x0[1]) + (x0[2] * x0[2] + x0[3] * x0[3]) + (x1[0] * x1[0] + x1[1] * x1[1]) + (x1[2] * x1[2] + x1[3] * x1[3]);
                        q += __shfl_xor(q, 16); q += __shfl_xor(q, 32); if (fq == 0) P[r * 8 + bj * 4 + wc] = q;
                    } else { const v4u xw = rxb[m];
                        *(f32x4*)(yo + off) = (f32x4){bflo(xw.x), bfhi(xw.x), bflo(xw.y), bfhi(xw.y)} + a0; *(f32x4*)(yo + off + 4) = (f32x4){bflo(xw.z), bfhi(xw.z), bflo(xw.w), bfhi(xw.w)} + a1; } }
                asm volatile("" ::: "memory"); } }
        if (LAYER == 0) {
            asm volatile("s_waitcnt lgkmcnt(0)" ::: "memory"); __builtin_amdgcn_s_barrier(); asm volatile("" ::: "memory");
            if (lane < 32) { const LAS float* p = P + prow * 8; sq2[(size_t)(u.pm * 256 + prow) * 8 + u.pn] = ((p[0] + p[1]) + (p[2] + p[3])) + ((p[4] + p[5]) + (p[6] + p[7])); } }
    }
};
struct EpiG4 {
    static constexpr bool PERM = false, AFTER_DRAIN = false, PERMA = false;
    float* out; bf16* KB; bf16* VT; bf16* QB; bf16* G2; const float* sq2;
    __device__ __forceinline__ void operator()(const f32x4 (&acc)[2][2][4][2], const Unit& u, int wr, int wc, int fr, int fq) const {
        const int row0 = u.pm * 256 + wr * 64 + fr, pn = u.pn;
        float rsr[2][4];
#pragma unroll
        for (int ai = 0; ai < 2; ++ai)
#pragma unroll
            for (int m = 0; m < 4; ++m) { const int row = row0 + ai * 128 + m * 16; rsr[ai][m] = 0.f;
                if (row < MREAL) { const f32x4 a = *(const f32x4*)(sq2 + (size_t)row * 8), b = *(const f32x4*)(sq2 + (size_t)row * 8 + 4); rsr[ai][m] = 1.0f / sqrtf(((a[0] + a[1]) + (a[2] + a[3]) + (b[0] + b[1]) + (b[2] + b[3])) * (1.0f / DM) + EPS); } }
#pragma unroll
        for (int ai = 0; ai < 2; ++ai)
#pragma unroll
            for (int m = 0; m < 4; ++m) { const int row = row0 + ai * 128 + m * 16;
#pragma unroll
                for (int bj = 0; bj < 2; ++bj)
#pragma unroll
                    for (int n = 0; n < 2; ++n) { const int col = pn * 256 + bj * 128 + wc * 32 + n * 16 + 4 * fq; const f32x4 v = acc[ai][bj][m][n] * rsr[ai][m];
                        if (pn < 2) { const int cc = col;
                            if (row < MPROMPT) { *(f32x4*)(out + O_KP + (size_t)row * KVW + cc) = v; v2u w; w.x = pk2(v[0], v[1]); w.y = pk2(v[2], v[3]); *(v2u*)(KB + (size_t)row * KVW + cc) = w; }
                            else if (row < MREAL) *(f32x4*)(out + O_KS + (size_t)(row - MPROMPT) * KVW + cc) = v;
                        } else if (pn < 4) { const int cc = col - 512;
                            if (row < MPROMPT) { *(f32x4*)(out + O_VP + (size_t)row * KVW + cc) = v; const int b = row >> 12, t0 = row & 4095, t = (t0 & ~12) | ((t0 & 4) << 1) | ((t0 & 8) >> 1);
                                bf16* vt = VT + ((size_t)(b * 4 + (cc >> 7)) * 128 + (cc & 127)) * SEQ + t;
#pragma unroll
                                for (int j = 0; j < 4; ++j) vt[(size_t)j * SEQ] = (bf16)f2bf(v[j]); }
                            else if (row < MREAL) *(f32x4*)(out + O_VS + (size_t)(row - MPROMPT) * KVW + cc) = v;
                        } else if (pn < 12) { v2u w; w.x = pk2(v[0], v[1]); w.y = pk2(v[2], v[3]); *(v2u*)(QB + (size_t)row * DM + (col - 1024)) = w;
                        } else { v2u w; w.x = pk2(silu_f(v[0]), silu_f(v[1])); w.y = pk2(silu_f(v[2]), silu_f(v[3])); *(v2u*)(G2 + (size_t)row * DM + (col - 3072)) = w; } } }
    }
};

__device__ __forceinline__ float wave_sum(float v) {
#pragma unroll
    for (int o = 1; o < 64; o <<= 1) v += __shfl_xor(v, o);
    return v;
}
__device__ __forceinline__ void tr_item(const float* W, int ldw, int K, int nblk, bf16* WT, int item, const float* gain, float scale, LAS float* scr, int lane) {
    const int kb = item / nblk, nb = item % nblk, k0 = 64 * kb, n0 = 32 * nb;
    float wv[32];
#pragma unroll
    for (int i = 0; i < 32; ++i) wv[i] = W[(size_t)(k0 + 2 * i + (lane >> 5)) * ldw + n0 + (lane & 31)];
#pragma unroll
    for (int i = 0; i < 32; ++i) { const int kk = 2 * i + (lane >> 5); const float g = gain ? gain[k0 + kk] * scale : scale; scr[kk * 33 + (lane & 31)] = wv[i] * g; }
    LDS_WAIT(); asm volatile("" ::: "memory");
    const int c = lane & 7;
#pragma unroll
    for (int j = 0; j < 4; ++j) { const int n = (lane >> 3) + 8 * j; const LAS float* s = scr + (8 * c) * 33 + n;
        v4u o; o.x = pk2(s[0 * 33], s[1 * 33]); o.y = pk2(s[2 * 33], s[3 * 33]); o.z = pk2(s[4 * 33], s[5 * 33]); o.w = pk2(s[6 * 33], s[7 * 33]);
        *(GAS v4u*)(WT + (size_t)(n0 + n) * K + k0 + 8 * c) = o; }
    LDS_WAIT(); asm volatile("" ::: "memory");
}
__device__ __forceinline__ void load_row8(const float* p, int lane, f32x4 (&v)[8]) {
#pragma unroll
    for (int j = 0; j < 8; ++j) v[j] = ((const f32x4*)p)[64 * j + lane];
}
__device__ __forceinline__ void load_row8_bf16(const bf16* p, int lane, f32x4 (&v)[8]) {
#pragma unroll
    for (int j = 0; j < 8; ++j) { const v2u w = ((const v2u*)p)[64 * j + lane]; v[j] = (f32x4){bflo(w.x), bfhi(w.x), bflo(w.y), bfhi(w.y)}; }
}
__device__ __forceinline__ float sumsq8(const f32x4 (&v)[8]) { float s = 0.f;
#pragma unroll
    for (int j = 0; j < 8; ++j) s += (v[j].x * v[j].x + v[j].y * v[j].y) + (v[j].z * v[j].z + v[j].w * v[j].w);
    return s; }
__device__ __forceinline__ void store_row8_bf16(bf16* o, int lane, const f32x4 (&v)[8], float s) {
#pragma unroll
    for (int j = 0; j < 8; ++j) { v2u w; w.x = pk2(v[j].x * s, v[j].y * s); w.y = pk2(v[j].z * s, v[j].w * s); ((v2u*)o)[64 * j + lane] = w; }
}
__device__ __forceinline__ void unpack8(const v4u w, float (&x)[8]) { x[0] = bflo(w.x); x[1] = bfhi(w.x); x[2] = bflo(w.y); x[3] = bfhi(w.y); x[4] = bflo(w.z); x[5] = bfhi(w.z); x[6] = bflo(w.w); x[7] = bfhi(w.w); }

namespace sba {
constexpr int KROW = 272, VROW = 144, KT_BYTES = 64 * KROW, VT_BYTES = 128 * VROW;
constexpr int KB0 = 0, VB0 = 3 * KT_BYTES;
__device__ __forceinline__ int crow(int r, int hi) { return (r & 3) + 8 * (r >> 2) + 4 * hi; }
#define SB() __builtin_amdgcn_sched_barrier(0)
__device__ __forceinline__ v4u lds128(const LAS unsigned char* p) { return *(const LAS v4u*)p; }
template <bool QK, bool PV>
__device__ __forceinline__ void hstep(const LAS unsigned char* kpN, const LAS unsigned char* vpP, const LAS unsigned char* vpC, const bf16x8 (&qf)[8], const bf16x8 (&td)[2], float bias2, float& R,
                                      const bf16x8 (&paP)[2], f32x16& pc, bf16x8 (&paO)[2], f32x16 (&o)[4], v4u (&vpre)[3]) {
    v4u vf[8], kf[8]; unsigned lw[8], pw[8];
    if (PV) { vf[0] = vpre[0]; vf[1] = vpre[1]; vf[2] = vpre[2]; }
    f32x16 pn;
#pragma unroll
    for (int r = 0; r < 16; ++r) pn[r] = bias2;
    const float z0 = pc[0];
#pragma unroll
    for (int i = 0; i < 8; ++i) {
        if (i <= 4) { if (PV) vf[i + 3] = lds128(vpP + ((i + 3) >> 1) * 32 * VROW + ((i + 3) & 1) * 32); }
        else if (QK) kf[i - 5] = lds128(kpN + (i - 5) * 32);
        if (PV) o[i >> 1] = __builtin_amdgcn_mfma_f32_32x32x16_bf16(paP[i & 1], __builtin_bit_cast(bf16x8, vf[i]), o[i >> 1], 0, 0, 0);
        lw[i] = pk2(lg2(1.0f + ex2(pc[2 * i])), lg2(1.0f + ex2(pc[2 * i + 1]))); asm volatile("" : "+v"(lw[i]));
        SB();
    }
    pc = __builtin_amdgcn_mfma_f32_32x32x16_bf16(td[0], __builtin_bit_cast(bf16x8, (v4u){lw[0], lw[1], lw[2], lw[3]}), pc, 0, 0, 0);
    pc = __builtin_amdgcn_mfma_f32_32x32x16_bf16(td[1], __builtin_bit_cast(bf16x8, (v4u){lw[4], lw[5], lw[6], lw[7]}), pc, 0, 0, 0);
    SB();
#pragma unroll
    for (int i = 0; i < 8; ++i) {
        if (i <= 4) { if (QK) kf[i + 3] = lds128(kpN + (i + 3) * 32); }
        else vpre[i - 5] = lds128(vpC + ((i - 5) >> 1) * 32 * VROW + ((i - 5) & 1) * 32);
        if (QK) pn = __builtin_amdgcn_mfma_f32_32x32x16_bf16(__builtin_bit_cast(bf16x8, kf[i]), qf[i], pn, 0, 0, 0);
        if (i >= 2) { pw[i - 2] = pk2(ex2(pc[2 * i - 4] + R), ex2(pc[2 * i - 3] + R)); asm volatile("" : "+v"(pw[i - 2])); }
        SB();
    }
    pw[6] = pk2(ex2(pc[12] + R), ex2(pc[13] + R)); pw[7] = pk2(ex2(pc[14] + R), ex2(pc[15] + R));
    { const float tot = pc[0] - z0;
      const unsigned tb = __builtin_bit_cast(unsigned, tot); auto rr = __builtin_amdgcn_permlane32_swap(tb, tb, false, false); R += __builtin_bit_cast(float, (unsigned)rr[0]); }
    paO[0] = __builtin_bit_cast(bf16x8, (v4u){pw[0], pw[1], pw[2], pw[3]}); paO[1] = __builtin_bit_cast(bf16x8, (v4u){pw[4], pw[5], pw[6], pw[7]});
    pc = pn;
    SB();
}
__device__ __forceinline__ void p_unit(int b, int h, int qb, const bf16* QB, const bf16* KB, const bf16* VT, const bf16* G2, bf16* AO, float bias2, LAS unsigned char* lds) {
    int tid_ = threadIdx.x; asm volatile("" : "+v"(tid_));
    const int tid = tid_, lane = tid & 63, ql = lane & 31, h2 = lane >> 5; const int wid = __builtin_amdgcn_readfirstlane(tid >> 6);
    const int kvh = h >> 2, q0w = qb * 256 + wid * 32;
    const size_t rowbase = (size_t)b * SEQ;
    bf16x8 qf[8];
    { const bf16* qp = QB + (rowbase + q0w + ql) * DM + h * HD + 8 * h2;
#pragma unroll
      for (int s = 0; s < 8; ++s) qf[s] = *(const bf16x8*)(qp + 16 * s); }
    bf16x8 tdiag[2];
#pragma unroll
    for (int s = 0; s < 2; ++s)
#pragma unroll
        for (int j = 0; j < 8; ++j) { const int ki = 16 * s + 8 * (j >> 2) + 4 * h2 + (j & 3); tdiag[s][j] = (ki >= ql) ? (short)0xBF80 : (short)0; }
    f32x16 o[4];
#pragma unroll
    for (int d = 0; d < 4; ++d) o[d] = f32x16{};
    float R = 0.f;
    const int NT = 4 * (qb + 1);
    const bf16* kg = KB + rowbase * KVW + kvh * HD; const bf16* vg = VT + (size_t)(b * 4 + kvh) * HD * SEQ;
    v4u kr[2], vr[2];
    auto gloadk = [&](int tt) {
#pragma unroll
        for (int i = 0; i < 2; ++i) { const int cid = tid + 512 * i; kr[i] = *(const v4u*)(kg + (size_t)(64 * tt + (cid >> 4)) * KVW + (cid & 15) * 8); } };
    auto gloadv = [&](int tt) {
#pragma unroll
        for (int i = 0; i < 2; ++i) { const int cid = tid + 512 * i; vr[i] = *(const v4u*)(vg + (size_t)(cid >> 3) * SEQ + 64 * tt + (cid & 7) * 8); } };
    auto lstorek = [&](int koff) {
#pragma unroll
        for (int i = 0; i < 2; ++i) { const int cid = tid + 512 * i; *(LAS v4u*)(lds + koff + (cid >> 4) * KROW + (cid & 15) * 16) = kr[i]; } };
    auto lstorev = [&](int voff) {
#pragma unroll
        for (int i = 0; i < 2; ++i) { const int cid = tid + 512 * i; *(LAS v4u*)(lds + voff + (cid >> 3) * VROW + (cid & 7) * 16) = vr[i]; } };
    int kc = KB0, kn = KB0 + KT_BYTES, kf = KB0 + 2 * KT_BYTES, vo = VB0, vc = VB0 + VT_BYTES, vf = VB0 + 2 * VT_BYTES;
    gloadk(NT - 1); gloadv(NT - 1); lstorek(kc); lstorev(vc); gloadk(NT - 2); lstorek(kn);
    __syncthreads();
#define P_ROT() do { const int t_ = kc; kc = kn; kn = kf; kf = t_; const int u_ = vo; vo = vc; vc = vf; vf = u_; } while (0)
    auto qk = [&](const LAS unsigned char* kb, int blk) -> f32x16 {
        f32x16 p;
#pragma unroll
        for (int r = 0; r < 16; ++r) p[r] = bias2;
        const LAS unsigned char* kp = kb + (32 * blk + ql) * KROW + h2 * 16;
#pragma unroll
        for (int s = 0; s < 8; ++s) { const bf16x8 k0 = *(const LAS bf16x8*)(kp + s * 32); p = __builtin_amdgcn_mfma_f32_32x32x16_bf16(k0, qf[s], p, 0, 0, 0); }
        return p; };
    auto pv = [&](const LAS unsigned char* vb, int blk, const bf16x8 (&pa)[2]) {
        const LAS unsigned char* vp = vb + ql * VROW + h2 * 16 + blk * 64;
        v4u f[8];
#pragma unroll
        for (int i = 0; i < 8; ++i) f[i] = lds128(vp + (i >> 1) * 32 * VROW + (i & 1) * 32);
#pragma unroll
        for (int i = 0; i < 8; ++i) o[i >> 1] = __builtin_amdgcn_mfma_f32_32x32x16_bf16(pa[i & 1], __builtin_bit_cast(bf16x8, f[i]), o[i >> 1], 0, 0, 0);
    };
    const int gdiag = 8 * qb + wid;
    const int lv = ql * VROW + h2 * 16, lk = ql * KROW + h2 * 16;
    f32x16 pc; bf16x8 paP[2], paA[2]; v4u vpre[3];
#pragma unroll
    for (int r = 0; r < 16; ++r) pc[r] = 0.f;
    paP[0] = __builtin_bit_cast(bf16x8, (v4u){0u, 0u, 0u, 0u}); paP[1] = paP[0]; paA[0] = paP[0]; paA[1] = paP[0];
    vpre[0] = vpre[1] = vpre[2] = (v4u){0u, 0u, 0u, 0u};
    auto dmask = [&](f32x16& p) {
#pragma unroll
        for (int r = 0; r < 16; ++r) if ((r & 3) + 8 * (r >> 2) + 4 * h2 >= ql) p[r] = MASKV; };
#define P_HALF(QKF, g, kcur, blkc, kpn, vpp, vpcur, pin, pout) do { \
        if ((g) <= gdiag) { const bool st_ = (g) == gdiag;        \
            if (st_) { pc = qk(kcur, blkc); dmask(pc); } \
            hstep<QKF, true>(kpn, st_ ? (vpcur) : (vpp), vpcur, qf, tdiag, bias2, R, pin, pc, pout, o, vpre); } } while (0)
    int tt = NT - 1;
    for (; tt >= NT - 4 && tt >= 1; --tt) {
        if (tt > 1) gloadk(tt - 2);
        gloadv(tt - 1);
        P_HALF(true, 2 * tt + 1, lds + kc, 1, lds + kc + lk, lds + vo + lv, lds + vc + lv + 64, paP, paA);
        P_HALF(true, 2 * tt, lds + kc, 0, lds + kn + lk + 32 * KROW, lds + vc + lv + 64, lds + vc + lv, paA, paP);
        if (tt > 1) lstorek(kf);
        lstorev(vf);
        __syncthreads();
        P_ROT();
    }
    for (; tt >= 1; --tt) {
        if (tt > 1) gloadk(tt - 2);
        gloadv(tt - 1);
        hstep<true, true>(lds + kc + lk, lds + vo + lv, lds + vc + lv + 64, qf, tdiag, bias2, R, paP, pc, paA, o, vpre);
        hstep<true, true>(lds + kn + lk + 32 * KROW, lds + vc + lv + 64, lds + vc + lv, qf, tdiag, bias2, R, paA, pc, paP, o, vpre);
        if (tt > 1) lstorek(kf);
        lstorev(vf);
        __syncthreads();
        P_ROT();
    }
    P_HALF(true, 1, lds + kc, 1, lds + kc + lk, lds + vo + lv, lds + vc + lv + 64, paP, paA);
    P_HALF(false, 0, lds + kc, 0, lds + kc + lk, lds + vc + lv + 64, lds + vc + lv, paA, paP);
    pv(lds + vc, 0, paP);
    __syncthreads();
#undef P_HALF
#undef P_ROT
    {
        LAS float* ost = (LAS float*)(lds + wid * 16384);
#pragma unroll
        for (int d = 0; d < 4; ++d)
#pragma unroll
            for (int r = 0; r < 16; ++r) ost[crow(r, h2) * 128 + d * 32 + ql] = o[d][r];
        LDS_WAIT();
        const int rq = lane >> 4, c8 = (lane & 15) * 8;
#pragma unroll
        for (int i = 0; i < 8; ++i) { const int q = rq + 4 * i; const f32x4 a = *(const LAS f32x4*)(ost + q * 128 + c8), c = *(const LAS f32x4*)(ost + q * 128 + c8 + 4);
            const size_t off = (rowbase + q0w + q) * DM + h * HD + c8; const v4u g = *(const v4u*)(G2 + off);
            v4u w; w.x = pk2(a[0] * bflo(g.x), a[1] * bfhi(g.x)); w.y = pk2(a[2] * bflo(g.y), a[3] * bfhi(g.y)); w.z = pk2(c[0] * bflo(g.z), c[1] * bfhi(g.z)); w.w = pk2(c[2] * bflo(g.w), c[3] * bfhi(g.w));
            *(v4u*)(AO + off) = w; }
        LDS_WAIT();
        __syncthreads();
    }
}

__device__ __forceinline__ void s_waveunit(int wu, const float* CK, const float* CV, const int* PT, const bf16* QB, const float* blogit, float* PO, float* LT, LAS unsigned char* kl) {
    int lane_ = threadIdx.x & 63; asm volatile("" : "+v"(lane_));
    const int lane = lane_, n = lane & 15, kq = lane >> 4;
    const int pair = wu >> 4, c = wu & 15, sb = pair >> 2, kvh = pair & 3;
    const int head = kvh * 4 + (n & 3), mrow = MPROMPT + sb * 4 + (n >> 2);
    bf16x8 qf[4];
    { const bf16* qp = QB + (size_t)mrow * DM + head * HD + 8 * kq;
#pragma unroll
      for (int sl = 0; sl < 4; ++sl) qf[sl] = *(const bf16x8*)(qp + 32 * sl); }
    const float bias2 = blogit[head] * LOG2E;
    bf16x8 tA, tB, tN;
#pragma unroll
    for (int j = 0; j < 8; ++j) { const short m1 = (short)0xBF80;
        tA[j] = (j >= 4) ? m1 : ((4 * kq + j >= n) ? m1 : (short)0);
        tB[j] = (j >= 4) ? ((4 * kq + (j - 4) >= n) ? m1 : (short)0) : (short)0;
        tN[j] = m1; }
    f32x4 o[2][4];
#pragma unroll
    for (int hf = 0; hf < 2; ++hf)
#pragma unroll
        for (int i = 0; i < 4; ++i) o[hf][i] = (f32x4){0.f, 0.f, 0.f, 0.f};
    float R = 0.f;
    const int pg0 = __builtin_amdgcn_readfirstlane(PT[sb * NPG + 4 * c]), pg1 = __builtin_amdgcn_readfirstlane(PT[sb * NPG + 4 * c + 1]), pg2 = __builtin_amdgcn_readfirstlane(PT[sb * NPG + 4 * c + 2]), pg3 = __builtin_amdgcn_readfirstlane(PT[sb * NPG + 4 * c + 3]);
    f32x4 kr[2][4][2], vr[2][8];
    auto tokbase = [&](int blk) -> size_t { const int pgi = blk >> 2, page = pgi == 0 ? pg0 : pgi == 1 ? pg1 : pgi == 2 ? pg2 : pg3; return (size_t)page * 128 + ((32 * blk) & 127); };
    auto loadk = [&](int blk) { const size_t tb = tokbase(blk);
#pragma unroll
        for (int h = 0; h < 2; ++h)
#pragma unroll
            for (int sl = 0; sl < 4; ++sl) { const f32x4* kp = (const f32x4*)(CK + ((tb + 16 * h + 4 * sl + kq) * 4 + kvh) * HD + 4 * n); kr[h][sl][0] = *(kp); kr[h][sl][1] = *(kp + 16); } };
    auto loadv = [&](int blk) { const size_t tb = tokbase(blk);
#pragma unroll
        for (int j = 0; j < 8; ++j) { const int key = (j < 4) ? 4 * kq + j : 16 + 4 * kq + (j - 4); const f32x4* vp = (const f32x4*)(CV + ((tb + key) * 4 + kvh) * HD + 4 * n);
            vr[0][j] = *(vp); vr[1][j] = *(vp + 16); } };
    f32x4 z[2]; bf16x8 pb;
    auto qk_part = [&]() {
#pragma unroll
        for (int h = 0; h < 2; ++h)
#pragma unroll
            for (int sl = 0; sl < 4; ++sl) { const f32x4 a = kr[h][sl][0], b = kr[h][sl][1]; LAS unsigned char* kw = kl + (16 * h + 4 * sl + kq) * 272 + 8 * n;
                *(LAS v2u*)kw = (v2u){pk2(a[0], a[1]), pk2(a[2], a[3])}; *(LAS v2u*)(kw + 128) = (v2u){pk2(b[0], b[1]), pk2(b[2], b[3])}; }
#pragma unroll
        for (int h = 0; h < 2; ++h) { z[h] = (f32x4){bias2, bias2, bias2, bias2};
#pragma unroll
            for (int sl = 0; sl < 4; ++sl) { const bf16x8 kf = *(const LAS bf16x8*)(kl + (16 * h + n) * 272 + 64 * sl + 16 * kq);
                z[h] = __builtin_amdgcn_mfma_f32_16x16x32_bf16(kf, qf[sl], z[h], 0, 0, 0); } } };
    auto sb_part = [&]() {
        float L[8];
#pragma unroll
        for (int r = 0; r < 4; ++r) { L[r] = lg2(1.0f + ex2(z[0][r])); L[4 + r] = lg2(1.0f + ex2(z[1][r])); }
        v4u lw; lw.x = pk2(L[0], L[1]); lw.y = pk2(L[2], L[3]); lw.z = pk2(L[4], L[5]); lw.w = pk2(L[6], L[7]);
        const bf16x8 lb = __builtin_bit_cast(bf16x8, lw);
        f32x4 cA = z[0] + R, cB = z[1] + R, tot = (f32x4){0.f, 0.f, 0.f, 0.f};
        cA = __builtin_amdgcn_mfma_f32_16x16x32_bf16(tA, lb, cA, 0, 0, 0);
        cB = __builtin_amdgcn_mfma_f32_16x16x32_bf16(tB, lb, cB, 0, 0, 0);
        tot = __builtin_amdgcn_mfma_f32_16x16x32_bf16(tN, lb, tot, 0, 0, 0);
        v4u pw; pw.x = pk2(ex2(cA[0]), ex2(cA[1])); pw.y = pk2(ex2(cA[2]), ex2(cA[3])); pw.z = pk2(ex2(cB[0]), ex2(cB[1])); pw.w = pk2(ex2(cB[2]), ex2(cB[3]));
        pb = __builtin_bit_cast(bf16x8, pw);
        R += tot[0]; };
    auto pv_part = [&]() {
#pragma unroll
        for (int hf = 0; hf < 2; ++hf)
#pragma unroll
            for (int i = 0; i < 4; ++i) { v4u w; w.x = pk2(vr[hf][0][i], vr[hf][1][i]); w.y = pk2(vr[hf][2][i], vr[hf][3][i]); w.z = pk2(vr[hf][4][i], vr[hf][5][i]); w.w = pk2(vr[hf][6][i], vr[hf][7][i]);
                o[hf][i] = __builtin_amdgcn_mfma_f32_16x16x32_bf16(__builtin_bit_cast(bf16x8, w), pb, o[hf][i], 0, 0, 0); } };
    loadk(15); loadv(15);
    for (int blk = 15; blk >= 1; --blk) {
        qk_part(); __builtin_amdgcn_sched_barrier(0);
        loadk(blk - 1); __builtin_amdgcn_sched_barrier(0);
        sb_part(); pv_part(); __builtin_amdgcn_sched_barrier(0);
        loadv(blk - 1); __builtin_amdgcn_sched_barrier(0);
    }
    qk_part(); sb_part(); pv_part();
    float* po = PO + ((size_t)wu * 16 + n) * HD;
#pragma unroll
    for (int hf = 0; hf < 2; ++hf)
#pragma unroll
        for (int r = 0; r < 4; ++r) *(f32x4*)(po + 64 * hf + 16 * kq + 4 * r) = (f32x4){o[hf][0][r], o[hf][1][r], o[hf][2][r], o[hf][3][r]};
    if (kq == 0) LT[wu * 16 + n] = R;
}

__device__ __forceinline__ void s_combine(int pair, const float* out, const bf16* QB, const bf16* G2, const float* blogit, const float* PO, const float* LT, bf16* AO) {
    const int t = threadIdx.x, n = t >> 5, d = 4 * (t & 31);
    const int sb = pair >> 2, kvh = pair & 3, itok = n >> 2, head = kvh * 4 + (n & 3), mrow = MPROMPT + sb * 4 + itok;
    const size_t qoff = (size_t)mrow * DM + head * HD + d;
    const v2u qw = *(const v2u*)(QB + qoff);
    const float q4[4] = {bflo(qw.x), bfhi(qw.x), bflo(qw.y), bfhi(qw.y)};
    const float bias2 = blogit[head] * LOG2E;
    float R = 0.f; f32x4 O = (f32x4){0.f, 0.f, 0.f, 0.f};
#pragma unroll
    for (int j = 3; j >= 0; --j) {
        const f32x4 k4 = *(const f32x4*)(out + O_KS + (size_t)(sb * 4 + j) * KVW + kvh * HD + d);
        float part = (q4[0] * k4[0] + q4[1] * k4[1]) + (q4[2] * k4[2] + q4[3] * k4[3]);
#pragma unroll
        for (int s = 1; s < 32; s <<= 1) part += __shfl_xor(part, s);
        if (j < itok) { const float z = part + bias2, L = lg2(1.0f + ex2(z)); R -= L; const float P = ex2(z + R);
            const f32x4 v4 = *(const f32x4*)(out + O_VS + (size_t)(sb * 4 + j) * KVW + kvh * HD + d); O += v4 * P; }
    }
    for (int c = 15; c >= 0; --c) { const float w = ex2(R); const f32x4 po = *(const f32x4*)(PO + ((size_t)(pair * 16 + c) * 16 + n) * HD + d); O += po * w; R += LT[(pair * 16 + c) * 16 + n]; }
    const v2u gw = *(const v2u*)(G2 + qoff);
    v2u w; w.x = pk2(O[0] * bflo(gw.x), O[1] * bfhi(gw.x)); w.y = pk2(O[2] * bflo(gw.y), O[3] * bfhi(gw.y));
    *(v2u*)(AO + qoff) = w;
}
}

struct Args { const float* in[24]; float* out; unsigned char* ws; int ph_lo, ph_hi, li, mode; };
__global__ void __launch_bounds__(NWAVES * 64, 2) yoco_fwd(Args args) {
    extern __shared__ __attribute__((aligned(16))) unsigned char lds_raw[];
    LAS unsigned char* lds = (LAS unsigned char*)lds_raw;
    volatile LAS unsigned* MISC = (volatile LAS unsigned*)(lds + MISC_OFF);
    const int tid0 = threadIdx.x;
    const int G = gridDim.x; const int bx = blockIdx.x; const int vcu = (G % 8 == 0) ? (bx % 8) * (G / 8) + bx / 8 : bx;
    unsigned char* ws = args.ws; float* out = args.out;
    gu32* ctl = (gu32*)(ws + WS_CTL);
    const float* x_prompt = args.in[0]; const float* x_sample = args.in[1]; const float* cache_k = args.in[2]; const float* cache_v = args.in[3];
    const float* state_conv = args.in[4]; const float* state_h = args.in[5]; const int* page_table = (const int*)args.in[6];
    const float* g_pre = args.in[7]; const float* g_post = args.in[8]; const float* a_w_in = args.in[9]; const float* a_conv_w = args.in[10]; const float* a_conv_b = args.in[11];
    const float* a_w_r = args.in[12]; const float* a_b_r = args.in[13]; const float* a_w_i = args.in[14]; const float* a_b_i = args.in[15]; const float* a_lambda = args.in[16];
    const float* a_w_out = args.in[17]; const float* kv_norm = args.in[18]; const float* w_k = args.in[19]; const float* w_v = args.in[20]; const float* b_w_in = args.in[21];
    const float* b_logit = args.in[22]; const float* b_w_out = args.in[23];
    bf16* W1T = (bf16*)(ws + WS_W1T); bf16* WGT = (bf16*)(ws + WS_WGT); bf16* W3T = (bf16*)(ws + WS_W3T); bf16* W4T = (bf16*)(ws + WS_W4T); bf16* W5T = (bf16*)(ws + WS_W5T);
    float* CL = (float*)(ws + WS_CL); float* SA = (float*)(ws + WS_SA); float* SB = (float*)(ws + WS_SB); float* LT = (float*)(ws + WS_LT); float* PO = (float*)(ws + WS_PO); float* XB = (float*)(ws + WS_XB); float* SQ2 = (float*)(ws + WS_SQ2);
    bf16* XN = (bf16*)(ws + WS_XN); bf16* XR = (bf16*)(ws + WS_XR); bf16* GT = (bf16*)(ws + WS_GT); bf16* XC = (bf16*)(ws + WS_XC); bf16* Y = (bf16*)(ws + WS_Y);
    unsigned* AB = (unsigned*)(ws + WS_AL); bf16* OUTB = (bf16*)(ws + WS_OUT); float* OUTS = (float*)(ws + WS_OUTS); bf16* X1B = (bf16*)(ws + WS_X1);
    bf16* KB = (bf16*)(ws + WS_KB); bf16* VT = (bf16*)(ws + WS_VT); bf16* QB = (bf16*)(ws + WS_QB); bf16* G2 = (bf16*)(ws + WS_G2); bf16* AO = (bf16*)(ws + WS_AO);

    for (int u = tid0; u < (LDS_BYTES - LDSCTL_OFF) / 4; u += NWAVES * 64) ((LAS unsigned*)(lds + LDSCTL_OFF))[u] = 0u;
    __syncthreads();
    const int lo = args.ph_lo, hi = args.ph_hi;
    XcdBarrier bar; bar.bar = (unsigned*)(ctl + CW_BAR) + args.li * XCD_BAR_WORDS; bar.x = 0; bar.st = nullptr;
    if (hi - lo > 1) bar = xcd_barrier_post((unsigned*)(ctl + CW_BAR) + args.li * XCD_BAR_WORDS, MISC + 8);
#define GRID_BAR() xcd_barrier(bar)
#ifndef TEST_ONLY_PHASE
#define TEST_ONLY_PHASE -1
#endif
#define IN(k) ((TEST_ONLY_PHASE < 0 || TEST_ONLY_PHASE == (k)) && lo <= (k) && (k) < hi)
#define BOTH(k) (IN(k) && IN((k) + 1))
    const int NGW = G * NWAVES, NGT = G * NWAVES * 64;
#define EARLY_S(G_, bx_) ((G_) == 256 && (bx_) >= 660 - 2 * 256)
#define PHASE_IDS() int tid_p = threadIdx.x; asm volatile("" : "+v"(tid_p)); const int tid = tid_p, lane = tid & 63, wave = __builtin_amdgcn_readfirstlane(tid >> 6), gw = vcu * NWAVES + wave, gt = vcu * (NWAVES * 64) + tid; (void)lane; (void)gw; (void)gt

    if (IN(0)) {
        PHASE_IDS();
        LAS float* scr = (LAS float*)(lds + RING_OFF + wave * 16384);
        constexpr int I_W1 = 32 * 160, I_WG = 40 * 16, NITEMS = I_W1 + I_WG;
        for (int it = gw; it < NITEMS; it += NGW) {
            int r = it;
            if (r < I_W1) { tr_item(a_w_in, 5120, 2048, 160, W1T, r, g_pre, 1.0f, scr, lane); continue; } r -= I_W1;
            const int sm = r >> 4, hb = sm >> 1, gi = sm & 1, nb = hb >> 1, hf = hb & 1;
            tr_item((gi ? a_w_i : a_w_r) + (size_t)nb * 65536 + 128 * hf, 256, 256, 4, WGT + (size_t)(hb * 256 + gi * 128) * 256, r & 15, nullptr, 1.0f, scr, lane);
        }
        for (int ch = gt; ch < DR; ch += NGT) CL[ch] = -8.0f * LOG2E * log1pf(expf(-a_lambda[ch]));
        for (int m = gw; m < MPAD; m += NGW) {
            bf16* orow = XN + (size_t)m * DM;
            if (m < MREAL) { const float* xr = (m < MPROMPT) ? x_prompt + (size_t)m * DM : x_sample + (size_t)(m - MPROMPT) * DM;
                f32x4 v[8]; load_row8(xr, lane, v); const float rs = 1.0f / sqrtf(wave_sum(sumsq8(v)) * (1.0f / DM) + EPS); store_row8_bf16(orow, lane, v, rs); }
            else {
#pragma unroll
                for (int j = 0; j < 8; ++j) ((v2u*)orow)[64 * j + lane] = (v2u){0u, 0u}; }
        }
        if (BOTH(0)) GRID_BAR();
    }
    if (IN(1)) {
        pg8::Gemm g{2048, 2048}; pg8::Order S; S.init(XN, W1T, 2048, 2048, 32, 20, 2048, 1, 32, 0, G, bx);
        EpiG1 E{XR, GT};
        pg8::gemm_phase<EpiG1, pg8::Order, true, true>(lds + RING_OFF, g, S, E);
        const int nbusy = (S.nP + S.nS) - ((S.nP + S.nS - 1) / G) * G;
        if (bx >= nbusy) {
            int tid_d = threadIdx.x; asm volatile("" : "+v"(tid_d)); const int lane_d = tid_d & 63, wave_d = __builtin_amdgcn_readfirstlane(tid_d >> 6);
            LAS float* scr = (LAS float*)(lds + RING_OFF + wave_d * 16384);
            constexpr int I_W3 = 40 * 64, I_WK = 32 * 16, I_WQ = 32 * 64, I_W5 = 32 * 64, NDEF = I_W3 + 2 * I_WK + 2 * I_WQ + I_W5;
            for (int it = (bx - nbusy) * NWAVES + wave_d; it < NDEF; it += (G - nbusy) * NWAVES) {
                int r = it;
                if (r < I_W3) { tr_item(a_w_out, 2048, 2560, 64, W3T, r, nullptr, 1.0f, scr, lane_d); continue; } r -= I_W3;
                if (r < I_WK) { tr_item(w_k, 512, 2048, 16, W4T, r, kv_norm, 1.0f, scr, lane_d); continue; } r -= I_WK;
                if (r < I_WK) { tr_item(w_v, 512, 2048, 16, W4T + (size_t)512 * 2048, r, kv_norm, 1.0f, scr, lane_d); continue; } r -= I_WK;
                if (r < I_WQ) { tr_item(b_w_in, 4096, 2048, 64, W4T + (size_t)1024 * 2048, r, g_pre + DM, QSCALE, scr, lane_d); continue; } r -= I_WQ;
                if (r < I_WQ) { tr_item(b_w_in + 2048, 4096, 2048, 64, W4T + (size_t)3072 * 2048, r, g_pre + DM, 1.0f, scr, lane_d); continue; } r -= I_WQ;
                tr_item(b_w_out, 2048, 2048, 64, W5T, r, nullptr, 1.0f, scr, lane_d);
            }
        }
        if (BOTH(1)) GRID_BAR();
    }
    if (IN(2)) {
        PHASE_IDS();
        for (int task = gt; task < 256 * 320 + 32 * 320; task += NGT) {
            const bool samp = task >= 256 * 320; const int tk = samp ? task - 256 * 320 : task; const int rb = tk / 320, cg = tk % 320, ch = 8 * cg;
            float w[4][8], cb[8], x3[8], x2[8], x1[8];
#pragma unroll
            for (int k = 0; k < 4; ++k) { const f32x4 a = *(const f32x4*)(a_conv_w + k * DR + ch), b = *(const f32x4*)(a_conv_w + k * DR + ch + 4);
                w[k][0] = a.x; w[k][1] = a.y; w[k][2] = a.z; w[k][3] = a.w; w[k][4] = b.x; w[k][5] = b.y; w[k][6] = b.z; w[k][7] = b.w; }
            { const f32x4 a = *(const f32x4*)(a_conv_b + ch), b = *(const f32x4*)(a_conv_b + ch + 4); cb[0] = a.x; cb[1] = a.y; cb[2] = a.z; cb[3] = a.w; cb[4] = b.x; cb[5] = b.y; cb[6] = b.z; cb[7] = b.w; }
            int m0, nrows;
            if (!samp) { m0 = 32 * rb; nrows = 32;
                if ((m0 & 4095) != 0) { unpack8(*(const v4u*)(XR + (size_t)(m0 - 3) * DR + ch), x3); unpack8(*(const v4u*)(XR + (size_t)(m0 - 2) * DR + ch), x2); unpack8(*(const v4u*)(XR + (size_t)(m0 - 1) * DR + ch), x1); }
                else {
#pragma unroll
                    for (int j = 0; j < 8; ++j) { x3[j] = 0.f; x2[j] = 0.f; x1[j] = 0.f; } }
            } else { m0 = MPROMPT + 4 * rb; nrows = 4; const float* sc = state_conv + (size_t)rb * 3 * DR + ch;
#pragma unroll
                for (int j = 0; j < 8; ++j) { x3[j] = sc[j]; x2[j] = sc[DR + j]; x1[j] = sc[2 * DR + j]; } }
            for (int r0 = 0; r0 < nrows; r0 += 4) {
                v4u xw[4];
#pragma unroll
                for (int i = 0; i < 4; ++i) xw[i] = *(const v4u*)(XR + (size_t)(m0 + r0 + i) * DR + ch);
#pragma unroll
                for (int i = 0; i < 4; ++i) {
                    float x0[8]; unpack8(xw[i], x0);
                    float xc[8];
#pragma unroll
                    for (int j = 0; j < 8; ++j) { xc[j] = cb[j] + w[0][j] * x3[j] + w[1][j] * x2[j] + w[2][j] * x1[j] + w[3][j] * x0[j]; x3[j] = x2[j]; x2[j] = x1[j]; x1[j] = x0[j]; }
                    v4u o; o.x = pk2(xc[0], xc[1]); o.y = pk2(xc[2], xc[3]); o.z = pk2(xc[4], xc[5]); o.w = pk2(xc[6], xc[7]);
                    *(v4u*)(XC + (size_t)(m0 + r0 + i) * DR + ch) = o;
                }
            }
            float* so = nullptr;
            if (samp) so = out + O_CVS + (size_t)rb * 3 * DR + ch;
            else if (((m0 + 32) & 4095) == 0) so = out + O_CVP + (size_t)(m0 >> 12) * 3 * DR + ch;
            if (so) {
#pragma unroll
                for (int j = 0; j < 8; ++j) { so[j] = x3[j]; so[DR + j] = x2[j]; so[2 * DR + j] = x1[j]; } }
        }
        if (BOTH(2)) GRID_BAR();
    }
    if (IN(3)) {
        pg8::Gemm g{DR, 256}; pg8::Order S; S.init(XC, WGT, DR, 256, 32, 20, 256, 1, 32, 1, G, bx);
        EpiLru E{XC, AB, a_b_r, a_b_i, CL, SA, SB, (LAS float*)(lds + LDSCTL_OFF + 1024)};
        pg8::gemm_phase<EpiLru, pg8::Order, true, true>(lds + RING_OFF, g, S, E);
        if (BOTH(3)) GRID_BAR();
    }
    if (IN(5)) {
        PHASE_IDS();
        for (int task = gt; task < 96 * (DR / 2); task += NGT) {
            if (task >= 64 * (DR / 2)) {
                const int ts = task - 64 * (DR / 2), sb = ts / (DR / 2), ch = 2 * (ts % (DR / 2)); const f32x2_t h0s = *(const f32x2_t*)(state_h + (size_t)sb * DR + ch); float h[2] = {h0s.x, h0s.y};
#pragma unroll
                for (int i = 0; i < 4; ++i) { const size_t o = (size_t)(MPROMPT + sb * 4 + i) * DR + ch; const v2u w = *(const v2u*)(AB + o); const unsigned g = *(const unsigned*)(GT + o);
                    h[0] = ex2(bflo(w.x)) * h[0] + bfhi(w.x); h[1] = ex2(bflo(w.y)) * h[1] + bfhi(w.y); *(unsigned*)(Y + o) = pk2(h[0] * bflo(g), h[1] * bfhi(g)); }
                *(f32x2_t*)(out + O_HS + (size_t)sb * DR + ch) = (f32x2_t){h[0], h[1]};
                continue; }
            const int bc = task / (DR / 2), ch = 2 * (task % (DR / 2)), b = bc >> 5, c = bc & 31; const size_t m0 = (size_t)b * SEQ + c * 128;
            float h0 = 0.f, h1 = 0.f;
            for (int cc0 = 0; cc0 < c; cc0 += 8) {
                f32x2_t sa[8], sb2[8];
#pragma unroll
                for (int j = 0; j < 8; ++j) { const int cc = (cc0 + j < c) ? cc0 + j : c - 1; sa[j] = *(const f32x2_t*)(SA + (size_t)(b * 32 + cc) * DR + ch); sb2[j] = *(const f32x2_t*)(SB + (size_t)(b * 32 + cc) * DR + ch); }
#pragma unroll
                for (int j = 0; j < 8; ++j) if (cc0 + j < c) { h0 = sa[j].x * h0 + sb2[j].x; h1 = sa[j].y * h1 + sb2[j].y; } }
            const unsigned* ap = AB + m0 * DR + ch; const bf16* gp = GT + m0 * DR + ch; bf16* yp = Y + m0 * DR + ch;
            for (int t = 0; t < 128; t += 16) { v2u w[16]; unsigned gg[16];
#pragma unroll
                for (int j = 0; j < 16; ++j) { w[j] = *(const v2u*)(ap + (size_t)(t + j) * DR); gg[j] = *(const unsigned*)(gp + (size_t)(t + j) * DR); }
#pragma unroll
                for (int j = 0; j < 16; ++j) { h0 = ex2(bflo(w[j].x)) * h0 + bfhi(w[j].x); h1 = ex2(bflo(w[j].y)) * h1 + bfhi(w[j].y); *(unsigned*)(yp + (size_t)(t + j) * DR) = pk2(h0 * bflo(gg[j]), h1 * bfhi(gg[j])); } }
            if (c == 31) *(f32x2_t*)(out + O_HP + (size_t)b * DR + ch) = (f32x2_t){h0, h1};
        }
        if (BOTH(5)) GRID_BAR();
    }
    if (IN(6)) {
        unsigned* sga = (unsigned*)(ctl + CW_SGA);
        pg8::Gemm g{DR, DR}; pg8::Order S; S.init(Y, W3T, DR, DR, 32, 8, DR, 10, 32, 0, G, bx);
        S.sig = sga; S.sig_lo = 0; S.sig_hi = 8; S.sig_wg = true;
        EpiNorm<0> E{ws, x_prompt, nullptr, g_post, args.li, (LAS float*)(lds + LDSCTL_OFF + 1024)};
        pg8::gemm_phase<EpiNorm<0>, pg8::Order, true, true>(lds + RING_OFF, g, S, E);
        if (bx >= G - 128) {
            PHASE_IDS();
            LAS float* red = (LAS float*)(lds + LDSCTL_OFF + 1024);
            if (wave == 0) { for (unsigned sp = 0; __hip_atomic_load(sga, __ATOMIC_RELAXED, __HIP_MEMORY_SCOPE_AGENT) < 80u && sp < (1u << 20); ++sp) __builtin_amdgcn_s_sleep(2);
                __builtin_amdgcn_fence(__ATOMIC_ACQUIRE, "agent"); asm volatile("s_waitcnt vmcnt(0)" ::: "memory"); }
            __syncthreads();
            const int ms = bx - (G - 128), m = MPROMPT + ms, c4 = wave * 256 + lane * 4;
            f32x4 t[10];
#pragma unroll
            for (int sp = 0; sp < 10; ++sp) t[sp] = *(const f32x4*)(OUTS + ((size_t)sp * 256 + ms) * DM + c4);
            const f32x4 xv = *(const f32x4*)(x_sample + (size_t)ms * DM + c4), gv = *(const f32x4*)(g_post + c4);
            f32x4 o = t[0];
#pragma unroll
            for (int sp = 1; sp < 10; ++sp) o += t[sp];
            const float q = wave_sum((o[0] * o[0] + o[1] * o[1]) + (o[2] * o[2] + o[3] * o[3]));
            if (lane == 0) red[wave] = q;
            __syncthreads();
            const float rs = 1.0f / sqrtf((((red[0] + red[1]) + (red[2] + red[3])) + ((red[4] + red[5]) + (red[6] + red[7]))) * (1.0f / DM) + EPS);
            const f32x4 x1 = xv + o * rs * gv;
            *(v2u*)(X1B + (size_t)m * DM + c4) = (v2u){pk2(x1[0], x1[1]), pk2(x1[2], x1[3])};
            const float q2 = wave_sum((x1[0] * x1[0] + x1[1] * x1[1]) + (x1[2] * x1[2] + x1[3] * x1[3]));
            if (lane == 0) SQ2[(size_t)m * 8 + wave] = q2;
        }
        if (BOTH(6)) GRID_BAR();
    }
    if (IN(8)) {
        unsigned* sig = (unsigned*)(ctl + CW_SIG + 64 * args.li);
        pg8::Gemm g{2048, 2048}; pg8::Order S; S.init(X1B, W4T, 2048, 2048, 32, 20, 2048, 1, 32, 0, G, bx);
        S.sfirst = true; S.sig = sig; S.sig_lo = 4; S.sig_hi = 12;
        EpiG4 E{out, KB, VT, QB, G2, SQ2};
        pg8::gemm_phase<EpiG4, pg8::Order, true, true>(lds + RING_OFF, g, S, E);
        if (EARLY_S(G, bx)) {
            PHASE_IDS();
            for (unsigned sp = 0; __hip_atomic_load(sig, __ATOMIC_RELAXED, __HIP_MEMORY_SCOPE_AGENT) < 64u && sp < (1u << 20); ++sp) __builtin_amdgcn_s_sleep(2);
            __builtin_amdgcn_fence(__ATOMIC_ACQUIRE, "agent");
            asm volatile("s_waitcnt vmcnt(0)" ::: "memory");
            if (wave < 4) for (int g8 = gw; g8 < 2048; g8 += NGW) { const int j = g8 >> 2; sba::s_waveunit((((j >> 4) * 4 + (g8 & 3)) << 4) | (j & 15), cache_k, cache_v, page_table, QB, b_logit, PO, LT, lds + RING_OFF + wave * 8704); }
        }
        if (BOTH(8)) GRID_BAR();
    }
    if (IN(9)) {
        PHASE_IDS();
        const int spos = (vcu % 5 == 0) ? 0 : (vcu % 5 == 4) ? 2 : 1;
        const bool early = EARLY_S(G, bx);
        for (int step = 0; step < 3; ++step) {
            if (step == spos && !(args.mode & 1) && (!early || wave >= 4)) for (int g8 = gw; g8 < 2048; g8 += NGW) { const int j = g8 >> 2; sba::s_waveunit((((j >> 4) * 4 + (g8 & 3)) << 4) | (j & 15), cache_k, cache_v, page_table, QB, b_logit, PO, LT, lds + RING_OFF + wave * 8704); }
            if (step == spos && !(args.mode & 1)) __syncthreads();
            if (step < 2 && !(args.mode & 2)) {
                if (G == 256) {
                    const int x = vcu >> 5, j = vcu & 31, t = j >> 2, b = x >> 2, h = (x & 3) * 4 + (j & 3);
                    const int qa = (t == 0) ? 13 : (t == 1) ? 12 : (t == 2) ? 11 : (t == 3) ? 8 : (t == 4) ? 7 : (t == 5) ? 15 : (t == 6) ? 14 : 10;
                    const int qc = (t == 0) ? 0 : (t == 1) ? 1 : (t == 2) ? 2 : (t == 3) ? 5 : (t == 4) ? 6 : (t == 5) ? 3 : (t == 6) ? 4 : 9;
                    const float bias2 = b_logit[h] * LOG2E; const bool longfirst = (j & 1) == 0;
                    sba::p_unit(b, h, ((step == 0) == longfirst) ? qa : qc, QB, KB, VT, G2, AO, bias2, lds + RING_OFF);
                } else for (int pu = vcu; pu < 256; pu += G) {
                    const int bh = pu >> 3, s = pu & 7, b = bh >> 4, h = bh & 15; const float bias2 = b_logit[h] * LOG2E; const bool longfirst = (pu & 1) == 0;
                    sba::p_unit(b, h, ((step == 0) == longfirst) ? 15 - s : s, QB, KB, VT, G2, AO, bias2, lds + RING_OFF);
                }
            }
        }
        if (BOTH(9)) GRID_BAR();
    }
    if (IN(11)) {
        unsigned* cmb = (unsigned*)(ctl + CW_CMB + 64 * args.li);
        { PHASE_IDS();
          const int half = G / 2; int ndone = 0;
          if (bx >= half) for (int pair = bx - half; pair < 128; pair += G - half) { sba::s_combine(pair, out, QB, G2, b_logit, PO, LT, AO); ++ndone; }
          if (ndone) { asm volatile("s_waitcnt vmcnt(0)" ::: "memory"); __syncthreads();
              if (tid == 0) { __builtin_amdgcn_fence(__ATOMIC_RELEASE, "agent"); asm volatile("s_waitcnt vmcnt(0)" ::: "memory"); (void)__hip_atomic_fetch_add(cmb, (unsigned)ndone, __ATOMIC_RELAXED, __HIP_MEMORY_SCOPE_AGENT); } } }
        pg8::Gemm g{DM, DM}; pg8::Order S; S.init(AO, W5T, DM, DM, 32, 8, DM, 8, 32, 0, G, bx);
        S.wait_cnt = cmb; S.wait_n = 128u;
        EpiOut E{OUTB, OUTS, DM};
        pg8::gemm_phase<EpiOut, pg8::Order, true, true>(lds + RING_OFF, g, S, E);
        if (BOTH(11)) GRID_BAR();
    }
    if (IN(12)) {
        PHASE_IDS();
        f32x4 gp[8]; load_row8(g_post + DM, lane, gp);
        for (int m = gw; m < MREAL; m += NGW) {
            f32x4 o[8], x[8]; load_row8_bf16(X1B + (size_t)m * DM, lane, x);
            if (m < MPROMPT) load_row8_bf16(OUTB + (size_t)m * DM, lane, o);
            else { load_row8(OUTS + (size_t)(m - MPROMPT) * DM, lane, o);
                for (int sp = 1; sp < 8; ++sp) { f32x4 t[8]; load_row8(OUTS + ((size_t)sp * 256 + (m - MPROMPT)) * DM, lane, t);
#pragma unroll
                    for (int j = 0; j < 8; ++j) o[j] += t[j]; } }
            const float rs = 1.0f / sqrtf(wave_sum(sumsq8(o)) * (1.0f / DM) + EPS);
            float* yo = (m < MPROMPT) ? out + O_YP + (size_t)m * DM : out + O_YS + (size_t)(m - MPROMPT) * DM;
#pragma unroll
            for (int j = 0; j < 8; ++j) ((f32x4*)yo)[64 * j + lane] = x[j] + o[j] * rs * gp[j];
        }
    }
#undef IN
#undef BOTH
#undef GRID_BAR
}

extern "C" void kernel_launch(void* const* d_in, const int* in_sizes, int n_in, void* d_out, int out_size, void* d_ws, size_t ws_size, hipStream_t stream) {
    static int grid = 0;
    if (grid == 0) {
        if (n_in != 24 || (size_t)out_size != O_END || ws_size < WS_END) { fprintf(stderr, "kernel_launch: unexpected shapes: n_in %d out %d ws %zu\n", n_in, out_size, ws_size); grid = -1; return; }
        int dev = 0, cus = 0, per_cu = 0;
        if (hipGetDevice(&dev) != hipSuccess || hipDeviceGetAttribute(&cus, hipDeviceAttributeMultiprocessorCount, dev) != hipSuccess) { grid = -1; return; }
        if (hipFuncSetAttribute((const void*)yoco_fwd, hipFuncAttributeMaxDynamicSharedMemorySize, LDS_BYTES) != hipSuccess) { fprintf(stderr, "kernel_launch: hipFuncSetAttribute failed\n"); grid = -1; return; }
        if (hipOccupancyMaxActiveBlocksPerMultiprocessor(&per_cu, (const void*)yoco_fwd, NWAVES * 64, LDS_BYTES) != hipSuccess || per_cu < 1)
            fprintf(stderr, "kernel_launch: occupancy query reports %d workgroups per CU\n", per_cu);
        (void)hipGetLastError();
        grid = cus;
    }
    if (grid < 0) return;
    if (hipMemsetAsync((char*)d_ws + WS_CTL, 0, CTL_ZERO_BYTES, stream) != hipSuccess) return;
    Args a{};
    for (int i = 0; i < 24; ++i) a.in[i] = (const float*)d_in[i];
    a.out = (float*)d_out; a.ws = (unsigned char*)d_ws;
    if (N_LAUNCHES == 1) { a.ph_lo = 0; a.ph_hi = NPHASE; a.li = 0; hipLaunchKernelGGL(yoco_fwd, dim3(grid), dim3(NWAVES * 64), LDS_BYTES, stream, a); }
    else for (int p = 0; p < NPHASE; ++p) { a.ph_lo = p; a.ph_hi = p + 1; a.li = p; hipLaunchKernelGGL(yoco_fwd, dim3(grid), dim3(NWAVES * 64), LDS_BYTES, stream, a); }
#ifdef PROBE_EXTRA
    { const int extra[] = {PROBE_EXTRA}; int li = 20;
      for (int pe : extra) { const int p = pe % 100; a.mode = pe / 100; a.ph_lo = p; a.ph_hi = p + 1; a.li = li++; hipLaunchKernelGGL(yoco_fwd, dim3(grid), dim3(NWAVES * 64), LDS_BYTES, stream, a); } }
#endif
}
```

```cpp
#include <hip/hip_runtime.h>
#include <cstdio>
#include <cstdint>

#ifndef MK_N_LAUNCHES
#define MK_N_LAUNCHES 1
#endif

namespace pg8 {
#define PG8_LAS __attribute__((address_space(3)))
typedef unsigned short bf16_t;
typedef short bf16x8 __attribute__((ext_vector_type(8)));
typedef float f32x4 __attribute__((ext_vector_type(4)));
typedef unsigned u32x4 __attribute__((ext_vector_type(4)));
typedef unsigned u32x2 __attribute__((ext_vector_type(2)));
constexpr int BM = 256, BK = 64, HALF = 128, HTB = HALF * BK * 2, STAGE_BYTES = 8 * HTB, NXCD = 8, WGM = 8;

__host__ __device__ __forceinline__ int lds_byte(int r, int c) { const int st = (r >> 4) * 2 + (c >> 5), rr = r & 15, cc = c & 31, ob = rr * 64 + cc * 2; return st * 1024 + (ob ^ (((ob >> 9) & 1) << 5)); }
__host__ __device__ __forceinline__ void stage_rc(int b, int& R, int& C) { const int st = b / 1024, sb = b % 1024, swz = sb ^ (((sb >> 9) & 1) << 5); R = (st >> 1) * 16 + swz / 64; C = (st & 1) * 32 + (swz % 64) / 2; }
__host__ __device__ __forceinline__ int perm32(int rho) { const int n = rho >> 4, i = rho & 15; return 8 * (i >> 2) + 4 * n + (i & 3); }

struct Unit { int pm, pn, nt, aux; const char* a; const char* b; };
struct Gemm { int lda, ldb; };

struct Order {
    int nMp, nN, nP, nS, G, c, ntP, ntS, pmS, ablk;
    const char* A; const char* B; size_t tstepA, tstepB, ksplit;
    bool sfirst = false;
    bool sig_wg = false;
    unsigned* sig = nullptr; int sig_lo = 0, sig_hi = 0;
    unsigned* wait_cnt = nullptr; unsigned wait_n = 0;
    __device__ void init(const bf16_t* A_, const bf16_t* B_, int lda, int ldb, int nMp_, int nN_, int K, int nsplit, int pmS_, int ablk_, int G_, int c_) {
        A = (const char*)A_; B = (const char*)B_; nMp = nMp_; nN = nN_; nP = nMp * nN; nS = nN * nsplit; G = G_; c = c_; ntP = K / BK; ntS = K / nsplit / BK; pmS = pmS_; ablk = ablk_;
        tstepA = (size_t)BM * lda * 2; tstepB = (size_t)BM * ldb * 2; ksplit = (size_t)(K / nsplit) * 2; }
    __device__ bool next(int i, Unit& u) const {
        const long L0 = (long)i * G + c; if (L0 >= nP + nS) return false;
        const long L = sfirst ? (L0 < nS ? nP + L0 : L0 - nS) : L0;
        if (L < nP) {
            int wgid = (int)L; { const int q = nP / NXCD, r = nP % NXCD, xcd = wgid % NXCD, off = wgid / NXCD; wgid = (xcd < r ? xcd * (q + 1) : r * (q + 1) + (xcd - r) * q) + off; }
            const int nig = WGM * nN, gid = wgid / nig, fm = gid * WGM, gsz = (nMp - fm) < WGM ? (nMp - fm) : WGM;
            u.pm = fm + ((wgid % nig) % gsz); u.pn = (wgid % nig) / gsz; u.nt = ntP; u.aux = 0;
            u.a = A + (size_t)u.pm * tstepA + (ablk ? (size_t)(u.pn >> 1) * 512 : (size_t)0); u.b = B + (size_t)u.pn * tstepB;
        } else {
            const int j = (int)L - nP; u.pn = j % nN; u.aux = j / nN; u.pm = pmS; u.nt = ntS;
            u.a = A + (size_t)pmS * tstepA + (size_t)u.aux * ksplit + (ablk ? (size_t)(u.pn >> 1) * 512 : (size_t)0); u.b = B + (size_t)u.pn * tstepB + (size_t)u.aux * ksplit;
        }
        return true;
    }
    __device__ __forceinline__ void a_ready(const Unit& u) const {
        if (wait_cnt && u.pm == pmS) {
            for (unsigned sp = 0; __hip_atomic_load(wait_cnt, __ATOMIC_RELAXED, __HIP_MEMORY_SCOPE_AGENT) < wait_n && sp < (1u << 20); ++sp) __builtin_amdgcn_s_sleep(2);
            __builtin_amdgcn_fence(__ATOMIC_ACQUIRE, "agent");
            asm volatile("s_waitcnt vmcnt(0)" ::: "memory");
        } }
    __device__ __forceinline__ void done(const Unit& u) const {
        if (sig && sig_wg && u.pm == pmS && u.pn >= sig_lo && u.pn < sig_hi) {
            asm volatile("s_waitcnt vmcnt(0)" ::: "memory"); __syncthreads();
            if (threadIdx.x == 0) { __builtin_amdgcn_fence(__ATOMIC_RELEASE, "agent"); asm volatile("s_waitcnt vmcnt(0)" ::: "memory"); (void)__hip_atomic_fetch_add(sig, 1u, __ATOMIC_RELAXED, __HIP_MEMORY_SCOPE_AGENT); }
        } else if (sig && u.pm == pmS && u.pn >= sig_lo && u.pn < sig_hi) {
            asm volatile("s_waitcnt vmcnt(0)" ::: "memory");
            if ((threadIdx.x & 63) == 0) { __builtin_amdgcn_fence(__ATOMIC_RELEASE, "agent"); asm volatile("s_waitcnt vmcnt(0)" ::: "memory"); (void)__hip_atomic_fetch_add(sig, 1u, __ATOMIC_RELAXED, __HIP_MEMORY_SCOPE_AGENT); } } }
};

__device__ __forceinline__ unsigned cvt_pk_bf16(float lo, float hi) { unsigned r; asm volatile("v_cvt_pk_bf16_f32 %0, %1, %2" : "=v"(r) : "v"(lo), "v"(hi)); return r; }

template <class Epi, class Sched, bool ALIGN_EPI = false, bool SP2 = false>
__device__ __forceinline__ void gemm_phase(PG8_LAS unsigned char* lds, const Gemm g, const Sched& S, const Epi& E) {
    int tid_ = threadIdx.x; asm volatile("" : "+v"(tid_));
    const int tid = tid_, wid = __builtin_amdgcn_readfirstlane(tid >> 6), lane = tid & 63, wr = wid >> 2, wc = wid & 3, fr = lane & 15, fq = lane >> 4;
    unsigned voffA[2], voffB[2];
#pragma unroll
    for (int i = 0; i < 2; ++i) { int R, C; stage_rc(tid * 16 + i * 8192, R, C); const int Rb = Epi::PERM ? ((R & ~31) + perm32(R & 31)) : R;
        const int Ra = Epi::PERMA ? ((R & ~63) + 4 * (R & 15) + ((R >> 4) & 3)) : R;
        voffA[i] = (unsigned)(Ra * g.lda + C) * 2u; voffB[i] = (unsigned)(Rb * g.ldb + C) * 2u; }
    const size_t kstep = (size_t)(BK * 2);
    const size_t hstepA = (size_t)HALF * g.lda * 2, hstepB = (size_t)HALF * g.ldb * 2;
    const unsigned ldsw = (unsigned)wid * 1024u;
    const int aoff = lds_byte(wr * 64 + fr, fq * 8), boff = lds_byte(wc * 32 + fr, fq * 8);
#define PG8_SA(b, h) (((b) * 2 + (h)) * HTB)
#define PG8_SB(b, h) ((4 + (b) * 2 + (h)) * HTB)
#define PG8_STAGE(bufoff, gbase, voff) do { _Pragma("unroll") for (int _i = 0; _i < 2; ++_i) \
        __builtin_amdgcn_global_load_lds((const unsigned*)((const char*)(gbase) + (voff)[_i]), (PG8_LAS unsigned*)(lds + (bufoff) + ldsw + _i * 8192), 16, 0, 0); } while (0)
#define PG8_LDA(dst, b, h) do { _Pragma("unroll") for (int m = 0; m < 4; ++m) _Pragma("unroll") for (int k = 0; k < 2; ++k) dst[m][k] = *(const PG8_LAS bf16x8*)(lds + PG8_SA(b, h) + aoff + m * 2048 + k * 1024); } while (0)
#define PG8_LDB(dst, b, h) do { _Pragma("unroll") for (int n = 0; n < 2; ++n) _Pragma("unroll") for (int k = 0; k < 2; ++k) dst[n][k] = *(const PG8_LAS bf16x8*)(lds + PG8_SB(b, h) + boff + n * 2048 + k * 1024); } while (0)
#define PG8_MMA(ai, bj, At, Bt) do { __builtin_amdgcn_s_setprio(1); _Pragma("unroll") for (int m = 0; m < 4; ++m) _Pragma("unroll") for (int n = 0; n < 2; ++n) _Pragma("unroll") for (int k = 0; k < 2; ++k) \
        acc[ai][bj][m][n] = __builtin_amdgcn_mfma_f32_16x16x32_bf16(Bt[n][k], At[m][k], acc[ai][bj][m][n], 0, 0, 0); __builtin_amdgcn_s_setprio(0); } while (0)
#define PG8_WAIT_V(n) asm volatile("s_waitcnt vmcnt(" #n ")" ::: "memory")
#define PG8_WAIT_L(n) asm volatile("s_waitcnt lgkmcnt(" #n ")" ::: "memory")
#define PG8_BAR __builtin_amdgcn_s_barrier()
#define PG8_SCHED __builtin_amdgcn_sched_barrier(0)
    Unit cur, nxt; int ui = 0;
    if (!S.next(0, cur)) return;
    f32x4 acc[2][2][4][2];
#pragma unroll
    for (int a = 0; a < 2; ++a)
#pragma unroll
        for (int b = 0; b < 2; ++b)
#pragma unroll
            for (int m = 0; m < 4; ++m)
#pragma unroll
                for (int n = 0; n < 2; ++n) acc[a][b][m][n] = (f32x4){0.f, 0.f, 0.f, 0.f};
    bf16x8 At[4][2], B0[2][2], B1[2][2];
    const char* cA = cur.a; const char* cB = cur.b;
    S.a_ready(cur);
    if constexpr (SP2) {
        PG8_STAGE(PG8_SB(0, 0), cB, voffB); PG8_STAGE(PG8_SB(0, 1), cB + hstepB, voffB); PG8_STAGE(PG8_SA(0, 0), cA, voffA); PG8_STAGE(PG8_SA(0, 1), cA + hstepA, voffA);
        if (wr == 1) PG8_BAR;
        PG8_WAIT_V(2); PG8_BAR;
        PG8_STAGE(PG8_SB(1, 0), cB + kstep, voffB); PG8_STAGE(PG8_SA(1, 0), cA + kstep, voffA); PG8_STAGE(PG8_SB(1, 1), cB + hstepB + kstep, voffB);
        PG8_WAIT_V(6); PG8_BAR;
    } else {
        PG8_STAGE(PG8_SB(0, 0), cB, voffB); PG8_STAGE(PG8_SA(0, 0), cA, voffA); PG8_STAGE(PG8_SB(0, 1), cB + hstepB, voffB); PG8_STAGE(PG8_SA(0, 1), cA + hstepA, voffA);
        if (wr == 1) PG8_BAR;
        PG8_WAIT_V(4); PG8_BAR;
        PG8_STAGE(PG8_SB(1, 0), cB + kstep, voffB); PG8_STAGE(PG8_SA(1, 0), cA + kstep, voffA); PG8_STAGE(PG8_SB(1, 1), cB + hstepB + kstep, voffB);
        PG8_WAIT_V(6); PG8_BAR;
    }
    for (;;) {
        const bool has_next = S.next(ui + 1, nxt);
        const char* nA = has_next ? nxt.a : cA; const char* nB = has_next ? nxt.b : cB;
        const int nt = cur.nt;
        for (int t = 0; t < nt; t += 2) {
            const bool last = (t == nt - 2);
            const char* a1 = cA + (size_t)(t + 1) * kstep;
            const char* a2 = last ? nA : cA + (size_t)(t + 2) * kstep; const char* b2 = last ? nB : cB + (size_t)(t + 2) * kstep;
            const char* a3 = a2 + kstep; const char* b3 = b2 + kstep;
            if (last && has_next) S.a_ready(nxt);
            if constexpr (SP2) {
            PG8_LDB(B0, 0, 0); PG8_LDB(B1, 0, 1); PG8_SCHED; PG8_LDA(At, 0, 0); PG8_STAGE(PG8_SA(1, 1), a1 + hstepA, voffA);
            PG8_WAIT_V(8); PG8_WAIT_L(0); PG8_BAR; PG8_MMA(0, 0, At, B0); PG8_MMA(0, 1, At, B1); PG8_BAR; PG8_SCHED;
            PG8_LDA(At, 0, 1); PG8_STAGE(PG8_SB(0, 0), b2, voffB); PG8_STAGE(PG8_SB(0, 1), b2 + hstepB, voffB); PG8_STAGE(PG8_SA(0, 0), a2, voffA);
            PG8_WAIT_V(8); PG8_WAIT_L(0); PG8_BAR; PG8_MMA(1, 0, At, B0); PG8_MMA(1, 1, At, B1); PG8_BAR; PG8_SCHED;
            PG8_LDB(B0, 1, 0); PG8_LDB(B1, 1, 1); PG8_SCHED; PG8_LDA(At, 1, 0); PG8_STAGE(PG8_SA(0, 1), a2 + hstepA, voffA);
            PG8_WAIT_V(8); PG8_WAIT_L(0); PG8_BAR; PG8_MMA(0, 0, At, B0); PG8_MMA(0, 1, At, B1); PG8_BAR; PG8_SCHED;
            PG8_LDA(At, 1, 1); PG8_STAGE(PG8_SB(1, 0), b3, voffB); PG8_STAGE(PG8_SB(1, 1), b3 + hstepB, voffB); PG8_STAGE(PG8_SA(1, 0), a3, voffA);
            PG8_WAIT_V(8); PG8_WAIT_L(0); PG8_BAR; PG8_MMA(1, 0, At, B0); PG8_MMA(1, 1, At, B1); PG8_BAR; PG8_SCHED;
            } else {
            PG8_LDB(B0, 0, 0); PG8_SCHED; PG8_LDA(At, 0, 0); PG8_STAGE(PG8_SA(1, 1), a1 + hstepA, voffA);
            PG8_WAIT_L(8); PG8_BAR; PG8_WAIT_L(0); PG8_MMA(0, 0, At, B0); PG8_BAR; PG8_SCHED;
            PG8_LDB(B1, 0, 1); PG8_STAGE(PG8_SB(0, 0), b2, voffB);
            PG8_BAR; PG8_WAIT_L(0); PG8_MMA(0, 1, At, B1); PG8_BAR;
            PG8_LDA(At, 0, 1); PG8_STAGE(PG8_SA(0, 0), a2, voffA);
            PG8_BAR; PG8_WAIT_L(0); PG8_MMA(1, 0, At, B0); PG8_BAR; PG8_SCHED;
            PG8_STAGE(PG8_SB(0, 1), b2 + hstepB, voffB);
            PG8_WAIT_V(6); PG8_BAR; PG8_MMA(1, 1, At, B1); PG8_BAR;
            PG8_LDB(B0, 1, 0); PG8_SCHED; PG8_LDA(At, 1, 0); PG8_STAGE(PG8_SA(0, 1), a2 + hstepA, voffA);
            PG8_WAIT_L(8); PG8_BAR; PG8_WAIT_L(0); PG8_MMA(0, 0, At, B0); PG8_BAR; PG8_SCHED;
            PG8_LDB(B1, 1, 1); PG8_STAGE(PG8_SB(1, 0), b3, voffB);
            PG8_BAR; PG8_WAIT_L(0); PG8_MMA(0, 1, At, B1); PG8_BAR;
            PG8_LDA(At, 1, 1); PG8_STAGE(PG8_SA(1, 0), a3, voffA);
            PG8_BAR; PG8_WAIT_L(0); PG8_MMA(1, 0, At, B0); PG8_BAR; PG8_SCHED;
            PG8_STAGE(PG8_SB(1, 1), b3 + hstepB, voffB);
            PG8_WAIT_V(6); PG8_BAR; PG8_MMA(1, 1, At, B1); PG8_BAR;
            }
        }
        if constexpr (ALIGN_EPI) { if (wr == 0) PG8_BAR; }
        E(acc, cur, wr, wc, fr, fq); S.done(cur);
        if (!has_next) break;
#pragma unroll
        for (int a = 0; a < 2; ++a)
#pragma unroll
            for (int b = 0; b < 2; ++b)
#pragma unroll
                for (int m = 0; m < 4; ++m)
#pragma unroll
                    for (int n = 0; n < 2; ++n) acc[a][b][m][n] = (f32x4){0.f, 0.f, 0.f, 0.f};
        cur = nxt; cA = nA; cB = nB; ++ui;
        if constexpr (ALIGN_EPI) { if (wr == 1) PG8_BAR; }
    }
    PG8_WAIT_V(0);
    if constexpr (!ALIGN_EPI) { if (wr == 0) PG8_BAR; }
    PG8_BAR;
#undef PG8_SA
#undef PG8_SB
#undef PG8_STAGE
#undef PG8_LDA
#undef PG8_LDB
#undef PG8_MMA
#undef PG8_WAIT_V
#undef PG8_WAIT_L
#undef PG8_BAR
#undef PG8_SCHED
}
}

constexpr int NWAVES = 8;
constexpr int N_LAUNCHES = MK_N_LAUNCHES;
constexpr int NPHASE = 13;
constexpr int DM = 2048, SEQ = 4096, MPROMPT = 8192, MSAMP = 128, MREAL = 8320, MPAD = 8448;
constexpr int DR = 2560;
constexpr int HD = 128, KVW = 512;
constexpr int NPG = 64;
constexpr float EPS = 1e-6f;
constexpr float LOG2E = 1.4426950408889634f;
constexpr float QSCALE = 1.4426950408889634f / 11.313708498984761f;
constexpr float MASKV = -1.0e30f;
constexpr size_t O_YP = 0, O_YS = 16777216, O_CVP = 17039360, O_HP = 17054720, O_KP = 17059840, O_VP = 21254144, O_CVS = 25448448, O_HS = 25694208, O_KS = 25776128, O_VS = 25841664, O_END = 25907200;
constexpr size_t MiB = 1u << 20;
#if defined(PROBE_EXTRA) || MK_N_LAUNCHES != 1
constexpr int CW_PAN = 200000;
constexpr size_t WS_CTL = 0, CTL_ZERO_BYTES = 1 * MiB;
#else
constexpr int CW_PAN = 8192;
constexpr size_t WS_CTL = 0, CTL_ZERO_BYTES = (size_t)(8192 + 1024) * 4;
#endif
constexpr size_t WS_W1T = 2 * MiB, WS_WGT = 22 * MiB, WS_W3T = 25 * MiB, WS_W4T = 35 * MiB, WS_W5T = 55 * MiB;
constexpr size_t WS_CL = 63 * MiB, WS_SA = 64 * MiB, WS_SB = 65 * MiB, WS_LT = 66 * MiB, WS_PO = 67 * MiB;
constexpr size_t WS_XN = 84 * MiB, WS_XR = 117 * MiB, WS_GT = 159 * MiB, WS_XC = 201 * MiB, WS_Y = 243 * MiB;
constexpr size_t WS_AL = 285 * MiB, WS_BB = 368 * MiB, WS_OUT = 451 * MiB, WS_X1 = 517 * MiB;
constexpr size_t WS_KB = 583 * MiB, WS_VT = 592 * MiB, WS_QB = 600 * MiB, WS_G2 = 633 * MiB, WS_AO = 666 * MiB, WS_OUTS = 700 * MiB, WS_XB = 724 * MiB, WS_SQ2 = 726 * MiB, WS_END = 728 * MiB;
constexpr int CW_BAR = 4096;
constexpr int CW_SGA = 3584, CW_SGB = 3840;
constexpr int CW_SIG = 2048;
constexpr int CW_CMB = 1024;
constexpr int RING_OFF = 0, RING_BYTES = 131072;
constexpr int LDSCTL_OFF = RING_BYTES, MISC_OFF = LDSCTL_OFF + 320;
constexpr int LDS_BYTES = 147456;

#define GAS __attribute__((address_space(1)))
#define LAS __attribute__((address_space(3)))
typedef unsigned short bf16;
typedef unsigned v4u __attribute__((ext_vector_type(4)));
typedef unsigned v2u __attribute__((ext_vector_type(2)));
typedef float f32x4 __attribute__((ext_vector_type(4)));
typedef float f32x16 __attribute__((ext_vector_type(16)));
typedef short bf16x8 __attribute__((ext_vector_type(8)));
typedef short s16x4 __attribute__((ext_vector_type(4)));
typedef GAS unsigned gu32;
#define RLX_AGENT __ATOMIC_RELAXED, __HIP_MEMORY_SCOPE_AGENT
#define LDS_WAIT() asm volatile("s_waitcnt lgkmcnt(0)" ::: "memory")
__device__ __forceinline__ unsigned f2bf(float f) { unsigned u = __builtin_bit_cast(unsigned, f); return (u + 0x7fffu + ((u >> 16) & 1u)) >> 16; }
typedef float f32x2_t __attribute__((ext_vector_type(2))); typedef __bf16 bf16x2_t __attribute__((ext_vector_type(2)));
__device__ __forceinline__ unsigned pk2(float lo, float hi) { f32x2_t v = {lo, hi}; bf16x2_t b = __builtin_convertvector(v, bf16x2_t); return __builtin_bit_cast(unsigned, b); }
__device__ __forceinline__ float bf2f(unsigned short b) { return __builtin_bit_cast(float, (unsigned)b << 16); }
__device__ __forceinline__ float bflo(unsigned w) { return __builtin_bit_cast(float, w << 16); }
__device__ __forceinline__ float bfhi(unsigned w) { return __builtin_bit_cast(float, w & 0xffff0000u); }
__device__ __forceinline__ float ex2(float x) { return __builtin_amdgcn_exp2f(x); }
__device__ __forceinline__ float lg2(float x) { return __builtin_amdgcn_logf(x); }
__device__ __forceinline__ float sigmoid_f(float x) { return __builtin_amdgcn_rcpf(1.f + ex2(-LOG2E * x)); }
__device__ __forceinline__ float silu_f(float x) { return x * sigmoid_f(x); }

#define XB_TMO      128
#define XB_XCNT(j)  (256  + 64 * (j))
#define XB_XSUB(j)  (1280 + 64 * (j))
#define XB_XGEN(j)  (2304 + 64 * (j))
#define XB_TOP      3328
#define XB_TOPGEN   3392
#define XCD_BAR_WORDS 3456
#define XB_SPIN_CAP (1u << 18)
__device__ __forceinline__ unsigned xb_ld(unsigned* p)              { return __hip_atomic_load(p, __ATOMIC_RELAXED, __HIP_MEMORY_SCOPE_AGENT); }
__device__ __forceinline__ unsigned xb_add(unsigned* p, unsigned v) { return __hip_atomic_fetch_add(p, v, __ATOMIC_RELAXED, __HIP_MEMORY_SCOPE_AGENT); }
__device__ __forceinline__ unsigned xb_xcc_id() { return (unsigned)__builtin_amdgcn_s_getreg((3 << 11) | 20) & 0xFu; }
#define XB_SPIN(cond, bar) do { unsigned _sp = 0; while (cond) { __builtin_amdgcn_s_sleep(1); \
    if ((++_sp & 255u) == 0u) { if (xb_ld(&(bar)[XB_TMO])) break; if (_sp > XB_SPIN_CAP) { atomicAdd(&(bar)[XB_TMO], 1u); break; } } } } while (0)
struct XcdBarrier { unsigned* bar; unsigned x; volatile LAS unsigned* st; };
__device__ __forceinline__ XcdBarrier xcd_barrier_post(unsigned* bar, volatile LAS unsigned* st) {
    XcdBarrier b; b.bar = bar; b.x = xb_xcc_id(); b.st = st;
    if (threadIdx.x == 0) (void)xb_add(&bar[XB_XCNT(b.x)], 1u);
    return b;
}
__device__ __forceinline__ void xcd_barrier_complete(unsigned* bar, unsigned x, unsigned& nloc, unsigned& nx) {
    const unsigned G = gridDim.x * gridDim.y * gridDim.z;
    unsigned sum, cnt, mine, sp = 0u;
    for (;;) {
        sum = 0u; cnt = 0u; mine = 0u;
#pragma unroll
        for (unsigned j = 0; j < 16; ++j) { const unsigned c = xb_ld(&bar[XB_XCNT(j)]); sum += c; cnt += (c > 0u) ? 1u : 0u; mine = (j == x) ? c : mine; }
        if (sum == G) break;
        __builtin_amdgcn_s_sleep(1);
        if ((++sp & 255u) == 0u) { if (xb_ld(&bar[XB_TMO])) break; if (sp > XB_SPIN_CAP) { atomicAdd(&bar[XB_TMO], 1u); break; } }
    }
    nloc = mine > 0u ? mine : 1u; nx = cnt > 0u ? cnt : 1u;
}
__device__ __forceinline__ void xcd_barrier(const XcdBarrier& b) {
    asm volatile("s_waitcnt vmcnt(0)" ::: "memory");
    __syncthreads();
    if (threadIdx.x == 0) {
        unsigned* bar = b.bar;
        __builtin_amdgcn_s_waitcnt(0);
        unsigned nloc = b.st[0], nx = b.st[1];
        if (nloc == 0u) { xcd_barrier_complete(bar, b.x, nloc, nx); b.st[0] = nloc; b.st[1] = nx; }
        const unsigned old = xb_add(&bar[XB_XSUB(b.x)], 1u);
        const unsigned gen = old / nloc;
        if (old + 1u == (gen + 1u) * nloc) {
            __builtin_amdgcn_fence(__ATOMIC_RELEASE, "agent");
            asm volatile("s_waitcnt vmcnt(0)" ::: "memory");
            const unsigned og = xb_add(&bar[XB_TOP], 1u);
            const unsigned tg = og / nx;
            if (og + 1u == (tg + 1u) * nx) xb_add(&bar[XB_TOPGEN], 1u);
            else XB_SPIN(xb_ld(&bar[XB_TOPGEN]) == tg, bar);
            __builtin_amdgcn_fence(__ATOMIC_ACQUIRE, "agent");
            xb_add(&bar[XB_XGEN(b.x)], 1u);
            asm volatile("s_waitcnt vmcnt(0)" ::: "memory");
        } else {
            XB_SPIN(xb_ld(&bar[XB_XGEN(b.x)]) == gen, bar);
            __builtin_amdgcn_fence(__ATOMIC_ACQUIRE, "agent");
            asm volatile("s_waitcnt vmcnt(0)" ::: "memory");
        }
    }
    __syncthreads();
}

using pg8::Unit;
struct EpiG1 {
    static constexpr bool PERM = true, AFTER_DRAIN = false, PERMA = false;
    bf16* XR; bf16* GT;
    __device__ __forceinline__ void operator()(const f32x4 (&acc)[2][2][4][2], const Unit& u, int wr, int wc, int fr, int fq) const {
        const bool gate = u.pn >= 10; bf16* base = gate ? GT : XR; const int colt = (gate ? u.pn - 10 : u.pn) * 256;
        const int row0 = u.pm * 256 + wr * 64 + fr, col0 = colt + wc * 32 + 8 * fq;
#pragma unroll
        for (int ai = 0; ai < 2; ++ai)
#pragma unroll
            for (int m = 0; m < 4; ++m) { bf16* rowp = base + (size_t)(row0 + ai * 128 + m * 16) * DR + col0;
#pragma unroll
                for (int bj = 0; bj < 2; ++bj) { f32x4 v0 = acc[ai][bj][m][0], v1 = acc[ai][bj][m][1];
                    if (gate) {
#pragma unroll
                        for (int j = 0; j < 4; ++j) { v0[j] = silu_f(v0[j]); v1[j] = silu_f(v1[j]); } }
                    v4u w; w.x = pk2(v0[0], v0[1]); w.y = pk2(v0[2], v0[3]); w.z = pk2(v1[0], v1[1]); w.w = pk2(v1[2], v1[3]);
                    *(v4u*)(rowp + bj * 128) = w; } }
    }
};
struct EpiF32 {
    static constexpr bool PERM = false, AFTER_DRAIN = false, PERMA = false;
    float* O; float* OS; int ldc;
    __device__ __forceinline__ void operator()(const f32x4 (&acc)[2][2][4][2], const Unit& u, int wr, int wc, int fr, int fq) const {
        float* base = (u.pm == 32) ? OS + (size_t)u.aux * 256 * ldc : O + (size_t)u.pm * 256 * ldc;
        const int row0 = wr * 64 + fr, col0 = u.pn * 256 + wc * 32 + 4 * fq;
#pragma unroll
        for (int ai = 0; ai < 2; ++ai)
#pragma unroll
            for (int m = 0; m < 4; ++m) { float* rowp = base + (size_t)(row0 + ai * 128 + m * 16) * ldc + col0;
#pragma unroll
                for (int bj = 0; bj < 2; ++bj)
#pragma unroll
                    for (int n = 0; n < 2; ++n) *(f32x4*)(rowp + bj * 128 + n * 16) = acc[ai][bj][m][n]; }
    }
};
struct EpiOut {
    static constexpr bool PERM = true, AFTER_DRAIN = false, PERMA = false;
    bf16* OB; float* OS; int ldc;
    __device__ __forceinline__ void operator()(const f32x4 (&acc)[2][2][4][2], const Unit& u, int wr, int wc, int fr, int fq) const {
        const int row0 = wr * 64 + fr, col0 = u.pn * 256 + wc * 32 + 8 * fq;
        if (u.pm == 32) { float* base = OS + (size_t)u.aux * 256 * ldc;
#pragma unroll
            for (int ai = 0; ai < 2; ++ai)
#pragma unroll
                for (int m = 0; m < 4; ++m) { float* rowp = base + (size_t)(row0 + ai * 128 + m * 16) * ldc + col0;
#pragma unroll
                    for (int bj = 0; bj < 2; ++bj) { *(f32x4*)(rowp + bj * 128) = acc[ai][bj][m][0]; *(f32x4*)(rowp + bj * 128 + 4) = acc[ai][bj][m][1]; } }
        } else { bf16* base = OB + (size_t)u.pm * 256 * ldc;
#pragma unroll
            for (int ai = 0; ai < 2; ++ai)
#pragma unroll
                for (int m = 0; m < 4; ++m) { bf16* rowp = base + (size_t)(row0 + ai * 128 + m * 16) * ldc + col0;
#pragma unroll
                    for (int bj = 0; bj < 2; ++bj) { const f32x4 v0 = acc[ai][bj][m][0], v1 = acc[ai][bj][m][1];
                        v4u w; w.x = pk2(v0[0], v0[1]); w.y = pk2(v0[2], v0[3]); w.z = pk2(v1[0], v1[1]); w.w = pk2(v1[2], v1[3]); *(v4u*)(rowp + bj * 128) = w; } }
        }
    }
};
__device__ __forceinline__ float dpp_shr(float old, float x, int sh) {
    const int o = __builtin_bit_cast(int, old), v = __builtin_bit_cast(int, x); int r;
    switch (sh) { case 1: r = __builtin_amdgcn_update_dpp(o, v, 0x111, 0xf, 0xf, false); break; case 2: r = __builtin_amdgcn_update_dpp(o, v, 0x112, 0xf, 0xf, false); break;
                  case 4: r = __builtin_amdgcn_update_dpp(o, v, 0x114, 0xf, 0xf, false); break; default: r = __builtin_amdgcn_update_dpp(o, v, 0x118, 0xf, 0xf, false); break; }
    return __builtin_bit_cast(float, r); }
struct EpiLru {
    static constexpr bool PERM = false, AFTER_DRAIN = false, PERMA = true;
    const bf16* XC; unsigned* AB; const float* b_r; const float* b_i; const float* cl; float* SA; float* SB; LAS float* xch;
    __device__ __forceinline__ void operator()(const f32x4 (&acc)[2][2][4][2], const Unit& u, int wr, int wc, int fr, int fq) const {
        const int chl = wc * 32 + 4 * fq, chb = u.pn * 128 + chl, trow = u.pm * 256 + wr * 64 + 4 * fr;
#pragma unroll
        for (int ai = 0; ai < 2; ++ai)
#pragma unroll
            for (int n = 0; n < 2; ++n) {
                const f32x4 br = *(const f32x4*)(b_r + chb + 16 * n), bi = *(const f32x4*)(b_i + chb + 16 * n), c4 = *(const f32x4*)(cl + chb + 16 * n);
                float As[4] = {1.f, 1.f, 1.f, 1.f}, Bs[4] = {0.f, 0.f, 0.f, 0.f};
#pragma unroll
                for (int m = 0; m < 4; ++m) { const size_t ro = (size_t)(trow + ai * 128 + m) * DR + chb + 16 * n;
                    const v2u xw = *(const v2u*)(XC + ro);
                    const float xc[4] = {bflo(xw.x), bfhi(xw.x), bflo(xw.y), bfhi(xw.y)};
                    const f32x4 ar = acc[ai][0][m][n] + br, ig = acc[ai][1][m][n] + bi;
                    v4u w;
#pragma unroll
                    for (int j = 0; j < 4; ++j) { const float r = sigmoid_f(ar[j]), ii = sigmoid_f(ig[j]); const float la = r * c4[j], a = ex2(la); const float om = __builtin_fmaf(-a, a, 1.0f);
                        const float bb = __builtin_amdgcn_sqrtf(__builtin_fmaxf(om, 0.f)) * ii * xc[j];
                        w[j] = pk2(la, bb);
                        Bs[j] = a * Bs[j] + bb; As[j] *= a; }
                    *(v4u*)(AB + ro) = w; }
#pragma unroll
                for (int j = 0; j < 4; ++j)
#pragma unroll
                    for (int sh = 1; sh < 16; sh <<= 1) { const float Al = dpp_shr(1.0f, As[j], sh), Bl = dpp_shr(0.0f, Bs[j], sh); Bs[j] = Bl * As[j] + Bs[j]; As[j] = Al * As[j]; }
                if (fr == 15) {
#pragma unroll
                    for (int j = 0; j < 4; ++j) { LAS float* p = xch + ((ai * 2 + wr) * 128 + chl + 16 * n + j) * 2; p[0] = As[j]; p[1] = Bs[j]; } }
            }
        asm volatile("s_waitcnt lgkmcnt(0)" ::: "memory"); __builtin_amdgcn_s_barrier(); asm volatile("" ::: "memory");
        const int t = (wr * 4 + wc) * 64 + fq * 16 + fr;
        if (t < 256 && u.pm < 32) { const int ai = t >> 7, c = t & 127; const LAS float* p0 = xch + ((ai * 2 + 0) * 128 + c) * 2; const LAS float* p1 = xch + ((ai * 2 + 1) * 128 + c) * 2;
            const float A0 = p0[0], B0 = p0[1], A1 = p1[0], B1 = p1[1];
            const size_t so = (size_t)((u.pm >> 4) * 32 + (u.pm & 15) * 2 + ai) * DR + u.pn * 128 + c;
            SA[so] = A0 * A1; SB[so] = B0 * A1 + B1; }
    }
};

template <int LAYER>
struct EpiNorm {
    static constexpr bool PERM = true, AFTER_DRAIN = false, PERMA = false;
    unsigned char* ws; const float* xf; float* yo; const float* gain; int li; LAS float* tab;
    __device__ __forceinline__ void operator()(const f32x4 (&acc)[2][2][4][2], const Unit& u, int wr, int wc, int fr_, int fq) const {
        int fr = fr_; asm volatile("" : "+v"(fr));
        const int row0 = wr * 64 + fr, col0 = u.pn * 256 + wc * 32 + 8 * fq; constexpr int ldc = DM;
        bf16* x1b = (bf16*)(ws + WS_X1); float* sq2 = (float*)(ws + WS_SQ2); float* OS = (float*)(ws + WS_OUTS); float* xb = (float*)(ws + WS_XB) + (size_t)LAYER * 65536;
        unsigned* cnt = (unsigned*)(ws + WS_CTL) + CW_PAN + (li * 2 + LAYER) * 512;
        if (u.pm == 32) { float* base = OS + (size_t)u.aux * 256 * ldc;
#pragma unroll
            for (int ai = 0; ai < 2; ++ai)
#pragma unroll
                for (int m = 0; m < 4; ++m) { float* rowp = base + (size_t)(row0 + ai * 128 + m * 16) * ldc + col0;
#pragma unroll
                    for (int bj = 0; bj < 2; ++bj) { *(f32x4*)(rowp + bj * 128) = acc[ai][bj][m][0]; *(f32x4*)(rowp + bj * 128 + 4) = acc[ai][bj][m][1]; } }
            return; }
        const int lane = fq * 16 + fr, wid = wr * 4 + wc;
        LAS float* P = tab; LAS float* Sr = tab + 2048;
#pragma unroll
        for (int ai = 0; ai < 2; ++ai)
#pragma unroll
            for (int m = 0; m < 4; ++m) { float q = 0.f;
#pragma unroll
                for (int bj = 0; bj < 2; ++bj)
#pragma unroll
                    for (int n = 0; n < 2; ++n) { const f32x4 v = acc[ai][bj][m][n]; q += (v[0] * v[0] + v[1] * v[1]) + (v[2] * v[2] + v[3] * v[3]); }
                q += __shfl_xor(q, 16); q += __shfl_xor(q, 32);
                if (fq == 0) P[(ai * 128 + row0 + m * 16) * 8 + wc] = q; }
        asm volatile("s_waitcnt lgkmcnt(0)" ::: "memory"); __builtin_amdgcn_s_barrier(); asm volatile("" ::: "memory");
        const int prow = wid * 32 + (lane & 31);
        if (lane < 32) { const float t = (P[prow * 8] + P[prow * 8 + 1]) + (P[prow * 8 + 2] + P[prow * 8 + 3]);
            __hip_atomic_store(xb + ((size_t)(u.pm * 256 + prow) * 8 + u.pn), t, __ATOMIC_RELAXED, __HIP_MEMORY_SCOPE_AGENT); }
        asm volatile("s_waitcnt vmcnt(0)" ::: "memory");
        if (lane == 0) (void)__hip_atomic_fetch_add(cnt + 16 * u.pm, 1u, __ATOMIC_RELAXED, __HIP_MEMORY_SCOPE_AGENT);
        if (wid == 0) { for (unsigned sp = 0; __hip_atomic_load(cnt + 16 * u.pm, __ATOMIC_RELAXED, __HIP_MEMORY_SCOPE_AGENT) < 64u && sp < (1u << 20); ++sp) __builtin_amdgcn_s_sleep(2);
            __builtin_amdgcn_fence(__ATOMIC_ACQUIRE, "agent"); }
        asm volatile("s_waitcnt vmcnt(0) lgkmcnt(0)" ::: "memory"); __builtin_amdgcn_s_barrier(); asm volatile("" ::: "memory");
        if (lane < 32) { const float* sl = xb + (size_t)(u.pm * 256 + prow) * 8; float t = 0.f;
#pragma unroll
            for (int k = 0; k < 8; ++k) t += __hip_atomic_load(sl + k, __ATOMIC_RELAXED, __HIP_MEMORY_SCOPE_AGENT);
            Sr[prow] = 1.0f / sqrtf(t * (1.0f / DM) + EPS); }
        asm volatile("s_waitcnt lgkmcnt(0)" ::: "memory"); __builtin_amdgcn_s_barrier(); asm volatile("" ::: "memory");
#pragma unroll
        for (int bj = 0; bj < 2; ++bj) { const f32x4 g0 = *(const f32x4*)(gain + col0 + bj * 128), g1 = *(const f32x4*)(gain + col0 + bj * 128 + 4);
#pragma unroll
            for (int ai = 0; ai < 2; ++ai) {
                f32x4 rx0[4], rx1[4]; v4u rxb[4];
#pragma unroll
                for (int m = 0; m < 4; ++m) { const size_t off = (size_t)(u.pm * 256 + ai * 128 + row0 + m * 16) * DM + col0 + bj * 128;
                    if (LAYER == 0) { rx0[m] = *(const f32x4*)(xf + off); rx1[m] = *(const f32x4*)(xf + off + 4); } else rxb[m] = *(const v4u*)(x1b + off); }
#pragma unroll
                for (int m = 0; m < 4; ++m) { const int r = ai * 128 + row0 + m * 16; const float rs = Sr[r]; const size_t off = (size_t)(u.pm * 256 + r) * DM + col0 + bj * 128;
                    const f32x4 a0 = acc[ai][bj][m][0] * rs * g0, a1 = acc[ai][bj][m][1] * rs * g1;
                    if (LAYER == 0) { const f32x4 x0 = rx0[m] + a0, x1 = rx1[m] + a1;
                        v4u w; w.x = pk2(x0[0], x0[1]); w.y = pk2(x0[2], x0[3]); w.z = pk2(x1[0], x1[1]); w.w = pk2(x1[2], x1[3]); *(v4u*)(x1b + off) = w;
                        float q = (x0[0] * x0[0] + x0[1] * x0[1]) + (x0[2] * x0[2] + x0[3] * x0[3]) + (x1[0] * x1[0] + x1[1] * x1[1]) + (x1[2] * x1[2] + x1[3] * x1[3]);
                        q += __shfl_xor(q, 16); q += __shfl_xor(q, 32); if (fq == 0) P[r * 8 + bj * 4 + wc] = q;
                    } else { const v4u xw = rxb[m];
                        *(f32x4*)(yo + off) = (f32x4){bflo(xw.x), bfhi(xw.x), bflo(xw.y), bfhi(xw.y)} + a0; *(f32x4*)(yo + off + 4) = (f32x4){bflo(xw.z), bfhi(xw.z), bflo(xw.w), bfhi(xw.w)} + a1; } }
                asm volatile("" ::: "memory"); } }
        if (LAYER == 0) {
            asm volatile("s_waitcnt lgkmcnt(0)" ::: "memory"); __builtin_amdgcn_s_barrier(); asm volatile("" ::: "memory");
            if (lane < 32) { const LAS float* p = P + prow * 8; sq2[(size_t)(u.pm * 256 + prow) * 8 + u.pn] = ((p[0] + p[1]) + (p[2] + p[3])) + ((p[4] + p[5]) + (p[6] + p[7])); } }
    }
};
struct EpiG4 {
    static constexpr bool PERM = false, AFTER_DRAIN = false, PERMA = false;
    float* out; bf16* KB; bf16* VT; bf16* QB; bf16* G2; const float* sq2;
    __device__ __forceinline__ void operator()(const f32x4 (&acc)[2][2][4][2], const Unit& u, int wr, int wc, int fr, int fq) const {
        const int row0 = u.pm * 256 + wr * 64 + fr, pn = u.pn;
        float rsr[2][4];
#pragma unroll
        for (int ai = 0; ai < 2; ++ai)
#pragma unroll
            for (int m = 0; m < 4; ++m) { const int row = row0 + ai * 128 + m * 16; rsr[ai][m] = 0.f;
                if (row < MREAL) { const f32x4 a = *(const f32x4*)(sq2 + (size_t)row * 8), b = *(const f32x4*)(sq2 + (size_t)row * 8 + 4); rsr[ai][m] = 1.0f / sqrtf(((a[0] + a[1]) + (a[2] + a[3]) + (b[0] + b[1]) + (b[2] + b[3])) * (1.0f / DM) + EPS); } }
#pragma unroll
        for (int ai = 0; ai < 2; ++ai)
#pragma unroll
            for (int m = 0; m < 4; ++m) { const int row = row0 + ai * 128 + m * 16;
#pragma unroll
                for (int bj = 0; bj < 2; ++bj)
#pragma unroll
                    for (int n = 0; n < 2; ++n) { const int col = pn * 256 + bj * 128 + wc * 32 + n * 16 + 4 * fq; const f32x4 v = acc[ai][bj][m][n] * rsr[ai][m];
                        if (pn < 2) { const int cc = col;
                            if (row < MPROMPT) { *(f32x4*)(out + O_KP + (size_t)row * KVW + cc) = v; v2u w; w.x = pk2(v[0], v[1]); w.y = pk2(v[2], v[3]); *(v2u*)(KB + (size_t)row * KVW + cc) = w; }
                            else if (row < MREAL) *(f32x4*)(out + O_KS + (size_t)(row - MPROMPT) * KVW + cc) = v;
                        } else if (pn < 4) { const int cc = col - 512;
                            if (row < MPROMPT) { *(f32x4*)(out + O_VP + (size_t)row * KVW + cc) = v; const int b = row >> 12, t0 = row & 4095, t = (t0 & ~12) | ((t0 & 4) << 1) | ((t0 & 8) >> 1);
                                bf16* vt = VT + ((size_t)(b * 4 + (cc >> 7)) * 128 + (cc & 127)) * SEQ + t;
#pragma unroll
                                for (int j = 0; j < 4; ++j) vt[(size_t)j * SEQ] = (bf16)f2bf(v[j]); }
                            else if (row < MREAL) *(f32x4*)(out + O_VS + (size_t)(row - MPROMPT) * KVW + cc) = v;
                        } else if (pn < 12) { v2u w; w.x = pk2(v[0], v[1]); w.y = pk2(v[2], v[3]); *(v2u*)(QB + (size_t)row * DM + (col - 1024)) = w;
                        } else { v2u w; w.x = pk2(silu_f(v[0]), silu_f(v[1])); w.y = pk2(silu_f(v[2]), silu_f(v[3])); *(v2u*)(G2 + (size_t)row * DM + (col - 3072)) = w; } } }
    }
};

__device__ __forceinline__ float wave_sum(float v) {
#pragma unroll
    for (int o = 1; o < 64; o <<= 1) v += __shfl_xor(v, o);
    return v;
}
__device__ __forceinline__ void tr_item(const float* W, int ldw, int K, int nblk, bf16* WT, int item, const float* gain, float scale, LAS float* scr, int lane) {
    const int kb = item / nblk, nb = item % nblk, k0 = 64 * kb, n0 = 32 * nb;
    float wv[32];
#pragma unroll
    for (int i = 0; i < 32; ++i) wv[i] = W[(size_t)(k0 + 2 * i + (lane >> 5)) * ldw + n0 + (lane & 31)];
#pragma unroll
    for (int i = 0; i < 32; ++i) { const int kk = 2 * i + (lane >> 5); const float g = gain ? gain[k0 + kk] * scale : scale; scr[kk * 33 + (lane & 31)] = wv[i] * g; }
    LDS_WAIT(); asm volatile("" ::: "memory");
    const int c = lane & 7;
#pragma unroll
    for (int j = 0; j < 4; ++j) { const int n = (lane >> 3) + 8 * j; const LAS float* s = scr + (8 * c) * 33 + n;
        v4u o; o.x = pk2(s[0 * 33], s[1 * 33]); o.y = pk2(s[2 * 33], s[3 * 33]); o.z = pk2(s[4 * 33], s[5 * 33]); o.w = pk2(s[6 * 33], s[7 * 33]);
        *(GAS v4u*)(WT + (size_t)(n0 + n) * K + k0 + 8 * c) = o; }
    LDS_WAIT(); asm volatile("" ::: "memory");
}
__device__ __forceinline__ void load_row8(const float* p, int lane, f32x4 (&v)[8]) {
#pragma unroll
    for (int j = 0; j < 8; ++j) v[j] = ((const f32x4*)p)[64 * j + lane];
}
__device__ __forceinline__ void load_row8_bf16(const bf16* p, int lane, f32x4 (&v)[8]) {
#pragma unroll
    for (int j = 0; j < 8; ++j) { const v2u w = ((const v2u*)p)[64 * j + lane]; v[j] = (f32x4){bflo(w.x), bfhi(w.x), bflo(w.y), bfhi(w.y)}; }
}
__device__ __forceinline__ float sumsq8(const f32x4 (&v)[8]) { float s = 0.f;
#pragma unroll
    for (int j = 0; j < 8; ++j) s += (v[j].x * v[j].x + v[j].y * v[j].y) + (v[j].z * v[j].z + v[j].w * v[j].w);
    return s; }
__device__ __forceinline__ void store_row8_bf16(bf16* o, int lane, const f32x4 (&v)[8], float s) {
#pragma unroll
    for (int j = 0; j < 8; ++j) { v2u w; w.x = pk2(v[j].x * s, v[j].y * s); w.y = pk2(v[j].z * s, v[j].w * s); ((v2u*)o)[64 * j + lane] = w; }
}
__device__ __forceinline__ void unpack8(const v4u w, float (&x)[8]) { x[0] = bflo(w.x); x[1] = bfhi(w.x); x[2] = bflo(w.y); x[3] = bfhi(w.y); x[4] = bflo(w.z); x[5] = bfhi(w.z); x[6] = bflo(w.w); x[7] = bfhi(w.w); }

namespace sba {
constexpr int KROW = 272, VROW = 144, KT_BYTES = 64 * KROW, VT_BYTES = 128 * VROW;
constexpr int KB0 = 0, VB0 = 3 * KT_BYTES;
__device__ __forceinline__ int crow(int r, int hi) { return (r & 3) + 8 * (r >> 2) + 4 * hi; }
#define SB() __builtin_amdgcn_sched_barrier(0)
__device__ __forceinline__ v4u lds128(const LAS unsigned char* p) { return *(const LAS v4u*)p; }
template <bool QK, bool PV>
__device__ __forceinline__ void hstep(const LAS unsigned char* kpN, const LAS unsigned char* vpP, const LAS unsigned char* vpC, const bf16x8 (&qf)[8], const bf16x8 (&td)[2], float bias2, float& R,
                                      const bf16x8 (&paP)[2], f32x16& pc, bf16x8 (&paO)[2], f32x16 (&o)[4], v4u (&vpre)[3]) {
    v4u vf[8], kf[8]; unsigned lw[8], pw[8];
    if (PV) { vf[0] = vpre[0]; vf[1] = vpre[1]; vf[2] = vpre[2]; }
    f32x16 pn;
#pragma unroll
    for (int r = 0; r < 16; ++r) pn[r] = bias2;
    const float z0 = pc[0];
#pragma unroll
    for (int i = 0; i < 8; ++i) {
        if (i <= 4) { if (PV) vf[i + 3] = lds128(vpP + ((i + 3) >> 1) * 32 * VROW + ((i + 3) & 1) * 32); }
        else if (QK) kf[i - 5] = lds128(kpN + (i - 5) * 32);
        if (PV) o[i >> 1] = __builtin_amdgcn_mfma_f32_32x32x16_bf16(paP[i & 1], __builtin_bit_cast(bf16x8, vf[i]), o[i >> 1], 0, 0, 0);
        lw[i] = pk2(lg2(1.0f + ex2(pc[2 * i])), lg2(1.0f + ex2(pc[2 * i + 1]))); asm volatile("" : "+v"(lw[i]));
        SB();
    }
    pc = __builtin_amdgcn_mfma_f32_32x32x16_bf16(td[0], __builtin_bit_cast(bf16x8, (v4u){lw[0], lw[1], lw[2], lw[3]}), pc, 0, 0, 0);
    pc = __builtin_amdgcn_mfma_f32_32x32x16_bf16(td[1], __builtin_bit_cast(bf16x8, (v4u){lw[4], lw[5], lw[6], lw[7]}), pc, 0, 0, 0);
    SB();
#pragma unroll
    for (int i = 0; i < 8; ++i) {
        if (i <= 4) { if (QK) kf[i + 3] = lds128(kpN + (i + 3) * 32); }
        else vpre[i - 5] = lds128(vpC + ((i - 5) >> 1) * 32 * VROW + ((i - 5) & 1) * 32);
        if (QK) pn = __builtin_amdgcn_mfma_f32_32x32x16_bf16(__builtin_bit_cast(bf16x8, kf[i]), qf[i], pn, 0, 0, 0);
        if (i >= 2) { pw[i - 2] = pk2(ex2(pc[2 * i - 4] + R), ex2(pc[2 * i - 3] + R)); asm volatile("" : "+v"(pw[i - 2])); }
        SB();
    }
    pw[6] = pk2(ex2(pc[12] + R), ex2(pc[13] + R)); pw[7] = pk2(ex2(pc[14] + R), ex2(pc[15] + R));
    { const float tot = pc[0] - z0;
      const unsigned tb = __builtin_bit_cast(unsigned, tot); auto rr = __builtin_amdgcn_permlane32_swap(tb, tb, false, false); R += __builtin_bit_cast(float, (unsigned)rr[0]); }
    paO[0] = __builtin_bit_cast(bf16x8, (v4u){pw[0], pw[1], pw[2], pw[3]}); paO[1] = __builtin_bit_cast(bf16x8, (v4u){pw[4], pw[5], pw[6], pw[7]});
    pc = pn;
    SB();
}
__device__ __forceinline__ void p_unit(int b, int h, int qb, const bf16* QB, const bf16* KB, const bf16* VT, const bf16* G2, bf16* AO, float bias2, LAS unsigned char* lds) {
    int tid_ = threadIdx.x; asm volatile("" : "+v"(tid_));
    const int tid = tid_, lane = tid & 63, ql = lane & 31, h2 = lane >> 5; const int wid = __builtin_amdgcn_readfirstlane(tid >> 6);
    const int kvh = h >> 2, q0w = qb * 256 + wid * 32;
    const size_t rowbase = (size_t)b * SEQ;
    bf16x8 qf[8];
    { const bf16* qp = QB + (rowbase + q0w + ql) * DM + h * HD + 8 * h2;
#pragma unroll
      for (int s = 0; s < 8; ++s) qf[s] = *(const bf16x8*)(qp + 16 * s); }
    bf16x8 tdiag[2];
#pragma unroll
    for (int s = 0; s < 2; ++s)
#pragma unroll
        for (int j = 0; j < 8; ++j) { const int ki = 16 * s + 8 * (j >> 2) + 4 * h2 + (j & 3); tdiag[s][j] = (ki >= ql) ? (short)0xBF80 : (short)0; }
    f32x16 o[4];
#pragma unroll
    for (int d = 0; d < 4; ++d) o[d] = f32x16{};
    float R = 0.f;
    const int NT = 4 * (qb + 1);
    const bf16* kg = KB + rowbase * KVW + kvh * HD; const bf16* vg = VT + (size_t)(b * 4 + kvh) * HD * SEQ;
    v4u kr[2], vr[2];
    auto gloadk = [&](int tt) {
#pragma unroll
        for (int i = 0; i < 2; ++i) { const int cid = tid + 512 * i; kr[i] = *(const v4u*)(kg + (size_t)(64 * tt + (cid >> 4)) * KVW + (cid & 15) * 8); } };
    auto gloadv = [&](int tt) {
#pragma unroll
        for (int i = 0; i < 2; ++i) { const int cid = tid + 512 * i; vr[i] = *(const v4u*)(vg + (size_t)(cid >> 3) * SEQ + 64 * tt + (cid & 7) * 8); } };
    auto lstorek = [&](int koff) {
#pragma unroll
        for (int i = 0; i < 2; ++i) { const int cid = tid + 512 * i; *(LAS v4u*)(lds + koff + (cid >> 4) * KROW + (cid & 15) * 16) = kr[i]; } };
    auto lstorev = [&](int voff) {
#pragma unroll
        for (int i = 0; i < 2; ++i) { const int cid = tid + 512 * i; *(LAS v4u*)(lds + voff + (cid >> 3) * VROW + (cid & 7) * 16) = vr[i]; } };
    int kc = KB0, kn = KB0 + KT_BYTES, kf = KB0 + 2 * KT_BYTES, vo = VB0, vc = VB0 + VT_BYTES, vf = VB0 + 2 * VT_BYTES;
    gloadk(NT - 1); gloadv(NT - 1); lstorek(kc); lstorev(vc); gloadk(NT - 2); lstorek(kn);
    __syncthreads();
#define P_ROT() do { const int t_ = kc; kc = kn; kn = kf; kf = t_; const int u_ = vo; vo = vc; vc = vf; vf = u_; } while (0)
    auto qk = [&](const LAS unsigned char* kb, int blk) -> f32x16 {
        f32x16 p;
#pragma unroll
        for (int r = 0; r < 16; ++r) p[r] = bias2;
        const LAS unsigned char* kp = kb + (32 * blk + ql) * KROW + h2 * 16;
#pragma unroll
        for (int s = 0; s < 8; ++s) { const bf16x8 k0 = *(const LAS bf16x8*)(kp + s * 32); p = __builtin_amdgcn_mfma_f32_32x32x16_bf16(k0, qf[s], p, 0, 0, 0); }
        return p; };
    auto pv = [&](const LAS unsigned char* vb, int blk, const bf16x8 (&pa)[2]) {
        const LAS unsigned char* vp = vb + ql * VROW + h2 * 16 + blk * 64;
        v4u f[8];
#pragma unroll
        for (int i = 0; i < 8; ++i) f[i] = lds128(vp + (i >> 1) * 32 * VROW + (i & 1) * 32);
#pragma unroll
        for (int i = 0; i < 8; ++i) o[i >> 1] = __builtin_amdgcn_mfma_f32_32x32x16_bf16(pa[i & 1], __builtin_bit_cast(bf16x8, f[i]), o[i >> 1], 0, 0, 0);
    };
    const int gdiag = 8 * qb + wid;
    const int lv = ql * VROW + h2 * 16, lk = ql * KROW + h2 * 16;
    f32x16 pc; bf16x8 paP[2], paA[2]; v4u vpre[3];
#pragma unroll
    for (int r = 0; r < 16; ++r) pc[r] = 0.f;
    paP[0] = __builtin_bit_cast(bf16x8, (v4u){0u, 0u, 0u, 0u}); paP[1] = paP[0]; paA[0] = paP[0]; paA[1] = paP[0];
    vpre[0] = vpre[1] = vpre[2] = (v4u){0u, 0u, 0u, 0u};
    auto dmask = [&](f32x16& p) {
#pragma unroll
        for (int r = 0; r < 16; ++r) if ((r & 3) + 8 * (r >> 2) + 4 * h2 >= ql) p[r] = MASKV; };
#define P_HALF(QKF, g, kcur, blkc, kpn, vpp, vpcur, pin, pout) do { \
        if ((g) <= gdiag) { const bool st_ = (g) == gdiag;        \
            if (st_) { pc = qk(kcur, blkc); dmask(pc); } \
            hstep<QKF, true>(kpn, st_ ? (vpcur) : (vpp), vpcur, qf, tdiag, bias2, R, pin, pc, pout, o, vpre); } } while (0)
    int tt = NT - 1;
    for (; tt >= NT - 4 && tt >= 1; --tt) {
        if (tt > 1) gloadk(tt - 2);
        gloadv(tt - 1);
        P_HALF(true, 2 * tt + 1, lds + kc, 1, lds + kc + lk, lds + vo + lv, lds + vc + lv + 64, paP, paA);
        P_HALF(true, 2 * tt, lds + kc, 0, lds + kn + lk + 32 * KROW, lds + vc + lv + 64, lds + vc + lv, paA, paP);
        if (tt > 1) lstorek(kf);
        lstorev(vf);
        __syncthreads();
        P_ROT();
    }
    for (; tt >= 1; --tt) {
        if (tt > 1) gloadk(tt - 2);
        gloadv(tt - 1);
        hstep<true, true>(lds + kc + lk, lds + vo + lv, lds + vc + lv + 64, qf, tdiag, bias2, R, paP, pc, paA, o, vpre);
        hstep<true, true>(lds + kn + lk + 32 * KROW, lds + vc + lv + 64, lds + vc + lv, qf, tdiag, bias2, R, paA, pc, paP, o, vpre);
        if (tt > 1) lstorek(kf);
        lstorev(vf);
        __syncthreads();
        P_ROT();
    }
    P_HALF(true, 1, lds + kc, 1, lds + kc + lk, lds + vo + lv, lds + vc + lv + 64, paP, paA);
    P_HALF(false, 0, lds + kc, 0, lds + kc + lk, lds + vc + lv + 64, lds + vc + lv, paA, paP);
    pv(lds + vc, 0, paP);
    __syncthreads();
#undef P_HALF
#undef P_ROT
    {
        LAS float* ost = (LAS float*)(lds + wid * 16384);
#pragma unroll
        for (int d = 0; d < 4; ++d)
#pragma unroll
            for (int r = 0; r < 16; ++r) ost[crow(r, h2) * 128 + d * 32 + ql] = o[d][r];
        LDS_WAIT();
        const int rq = lane >> 4, c8 = (lane & 15) * 8;
#pragma unroll
        for (int i = 0; i < 8; ++i) { const int q = rq + 4 * i; const f32x4 a = *(const LAS f32x4*)(ost + q * 128 + c8), c = *(const LAS f32x4*)(ost + q * 128 + c8 + 4);
            const size_t off = (rowbase + q0w + q) * DM + h * HD + c8; const v4u g = *(const v4u*)(G2 + off);
            v4u w; w.x = pk2(a[0] * bflo(g.x), a[1] * bfhi(g.x)); w.y = pk2(a[2] * bflo(g.y), a[3] * bfhi(g.y)); w.z = pk2(c[0] * bflo(g.z), c[1] * bfhi(g.z)); w.w = pk2(c[2] * bflo(g.w), c[3] * bfhi(g.w));
            *(v4u*)(AO + off) = w; }
        LDS_WAIT();
        __syncthreads();
    }
}

__device__ __forceinline__ void s_waveunit(int wu, const float* CK, const float* CV, const int* PT, const bf16* QB, const float* blogit, float* PO, float* LT, LAS unsigned char* kl) {
    int lane_ = threadIdx.x & 63; asm volatile("" : "+v"(lane_));
    const int lane = lane_, n = lane & 15, kq = lane >> 4;
    const int pair = wu >> 4, c = wu & 15, sb = pair >> 2, kvh = pair & 3;
    const int head = kvh * 4 + (n & 3), mrow = MPROMPT + sb * 4 + (n >> 2);
    bf16x8 qf[4];
    { const bf16* qp = QB + (size_t)mrow * DM + head * HD + 8 * kq;
#pragma unroll
      for (int sl = 0; sl < 4; ++sl) qf[sl] = *(const bf16x8*)(qp + 32 * sl); }
    const float bias2 = blogit[head] * LOG2E;
    bf16x8 tA, tB, tN;
#pragma unroll
    for (int j = 0; j < 8; ++j) { const short m1 = (short)0xBF80;
        tA[j] = (j >= 4) ? m1 : ((4 * kq + j >= n) ? m1 : (short)0);
        tB[j] = (j >= 4) ? ((4 * kq + (j - 4) >= n) ? m1 : (short)0) : (short)0;
        tN[j] = m1; }
    f32x4 o[2][4];
#pragma unroll
    for (int hf = 0; hf < 2; ++hf)
#pragma unroll
        for (int i = 0; i < 4; ++i) o[hf][i] = (f32x4){0.f, 0.f, 0.f, 0.f};
    float R = 0.f;
    const int pg0 = __builtin_amdgcn_readfirstlane(PT[sb * NPG + 4 * c]), pg1 = __builtin_amdgcn_readfirstlane(PT[sb * NPG + 4 * c + 1]), pg2 = __builtin_amdgcn_readfirstlane(PT[sb * NPG + 4 * c + 2]), pg3 = __builtin_amdgcn_readfirstlane(PT[sb * NPG + 4 * c + 3]);
    f32x4 kr[2][4][2], vr[2][8];
    auto tokbase = [&](int blk) -> size_t { const int pgi = blk >> 2, page = pgi == 0 ? pg0 : pgi == 1 ? pg1 : pgi == 2 ? pg2 : pg3; return (size_t)page * 128 + ((32 * blk) & 127); };
    auto loadk = [&](int blk) { const size_t tb = tokbase(blk);
#pragma unroll
        for (int h = 0; h < 2; ++h)
#pragma unroll
            for (int sl = 0; sl < 4; ++sl) { const f32x4* kp = (const f32x4*)(CK + ((tb + 16 * h + 4 * sl + kq) * 4 + kvh) * HD + 4 * n); kr[h][sl][0] = *(kp); kr[h][sl][1] = *(kp + 16); } };
    auto loadv = [&](int blk) { const size_t tb = tokbase(blk);
#pragma unroll
        for (int j = 0; j < 8; ++j) { const int key = (j < 4) ? 4 * kq + j : 16 + 4 * kq + (j - 4); const f32x4* vp = (const f32x4*)(CV + ((tb + key) * 4 + kvh) * HD + 4 * n);
            vr[0][j] = *(vp); vr[1][j] = *(vp + 16); } };
    f32x4 z[2]; bf16x8 pb;
    auto qk_part = [&]() {
#pragma unroll
        for (int h = 0; h < 2; ++h)
#pragma unroll
            for (int sl = 0; sl < 4; ++sl) { const f32x4 a = kr[h][sl][0], b = kr[h][sl][1]; LAS unsigned char* kw = kl + (16 * h + 4 * sl + kq) * 272 + 8 * n;
                *(LAS v2u*)kw = (v2u){pk2(a[0], a[1]), pk2(a[2], a[3])}; *(LAS v2u*)(kw + 128) = (v2u){pk2(b[0], b[1]), pk2(b[2], b[3])}; }
#pragma unroll
        for (int h = 0; h < 2; ++h) { z[h] = (f32x4){bias2, bias2, bias2, bias2};
#pragma unroll
            for (int sl = 0; sl < 4; ++sl) { const bf16x8 kf = *(const LAS bf16x8*)(kl + (16 * h + n) * 272 + 64 * sl + 16 * kq);
                z[h] = __builtin_amdgcn_mfma_f32_16x16x32_bf16(kf, qf[sl], z[h], 0, 0, 0); } } };
    auto sb_part = [&]() {
        float L[8];
#pragma unroll
        for (int r = 0; r < 4; ++r) { L[r] = lg2(1.0f + ex2(z[0][r])); L[4 + r] = lg2(1.0f + ex2(z[1][r])); }
        v4u lw; lw.x = pk2(L[0], L[1]); lw.y = pk2(L[2], L[3]); lw.z = pk2(L[4], L[5]); lw.w = pk2(L[6], L[7]);
        const bf16x8 lb = __builtin_bit_cast(bf16x8, lw);
        f32x4 cA = z[0] + R, cB = z[1] + R, tot = (f32x4){0.f, 0.f, 0.f, 0.f};
        cA = __builtin_amdgcn_mfma_f32_16x16x32_bf16(tA, lb, cA, 0, 0, 0);
        cB = __builtin_amdgcn_mfma_f32_16x16x32_bf16(tB, lb, cB, 0, 0, 0);
        tot = __builtin_amdgcn_mfma_f32_16x16x32_bf16(tN, lb, tot, 0, 0, 0);
        v4u pw; pw.x = pk2(ex2(cA[0]), ex2(cA[1])); pw.y = pk2(ex2(cA[2]), ex2(cA[3])); pw.z = pk2(ex2(cB[0]), ex2(cB[1])); pw.w = pk2(ex2(cB[2]), ex2(cB[3]));
        pb = __builtin_bit_cast(bf16x8, pw);
        R += tot[0]; };
    auto pv_part = [&]() {
#pragma unroll
        for (int hf = 0; hf < 2; ++hf)
#pragma unroll
            for (int i = 0; i < 4; ++i) { v4u w; w.x = pk2(vr[hf][0][i], vr[hf][1][i]); w.y = pk2(vr[hf][2][i], vr[hf][3][i]); w.z = pk2(vr[hf][4][i], vr[hf][5][i]); w.w = pk2(vr[hf][6][i], vr[hf][7][i]);
                o[hf][i] = __builtin_amdgcn_mfma_f32_16x16x32_bf16(__builtin_bit_cast(bf16x8, w), pb, o[hf][i], 0, 0, 0); } };
    loadk(15); loadv(15);
    for (int blk = 15; blk >= 1; --blk) {
        qk_part(); __builtin_amdgcn_sched_barrier(0);
        loadk(blk - 1); __builtin_amdgcn_sched_barrier(0);
        sb_part(); pv_part(); __builtin_amdgcn_sched_barrier(0);
        loadv(blk - 1); __builtin_amdgcn_sched_barrier(0);
    }
    qk_part(); sb_part(); pv_part();
    float* po = PO + ((size_t)wu * 16 + n) * HD;
#pragma unroll
    for (int hf = 0; hf < 2; ++hf)
#pragma unroll
        for (int r = 0; r < 4; ++r) *(f32x4*)(po + 64 * hf + 16 * kq + 4 * r) = (f32x4){o[hf][0][r], o[hf][1][r], o[hf][2][r], o[hf][3][r]};
    if (kq == 0) LT[wu * 16 + n] = R;
}

__device__ __forceinline__ void s_combine(int pair, const float* out, const bf16* QB, const bf16* G2, const float* blogit, const float* PO, const float* LT, bf16* AO) {
    const int t = threadIdx.x, n = t >> 5, d = 4 * (t & 31);
    const int sb = pair >> 2, kvh = pair & 3, itok = n >> 2, head = kvh * 4 + (n & 3), mrow = MPROMPT + sb * 4 + itok;
    const size_t qoff = (size_t)mrow * DM + head * HD + d;
    const v2u qw = *(const v2u*)(QB + qoff);
    const float q4[4] = {bflo(qw.x), bfhi(qw.x), bflo(qw.y), bfhi(qw.y)};
    const float bias2 = blogit[head] * LOG2E;
    float R = 0.f; f32x4 O = (f32x4){0.f, 0.f, 0.f, 0.f};
#pragma unroll
    for (int j = 3; j >= 0; --j) {
        const f32x4 k4 = *(const f32x4*)(out + O_KS + (size_t)(sb * 4 + j) * KVW + kvh * HD + d);
        float part = (q4[0] * k4[0] + q4[1] * k4[1]) + (q4[2] * k4[2] + q4[3] * k4[3]);
#pragma unroll
        for (int s = 1; s < 32; s <<= 1) part += __shfl_xor(part, s);
        if (j < itok) { const float z = part + bias2, L = lg2(1.0f + ex2(z)); R -= L; const float P = ex2(z + R);
            const f32x4 v4 = *(const f32x4*)(out + O_VS + (size_t)(sb * 4 + j) * KVW + kvh * HD + d); O += v4 * P; }
    }
    for (int c = 15; c >= 0; --c) { const float w = ex2(R); const f32x4 po = *(const f32x4*)(PO + ((size_t)(pair * 16 + c) * 16 + n) * HD + d); O += po * w; R += LT[(pair * 16 + c) * 16 + n]; }
    const v2u gw = *(const v2u*)(G2 + qoff);
    v2u w; w.x = pk2(O[0] * bflo(gw.x), O[1] * bfhi(gw.x)); w.y = pk2(O[2] * bflo(gw.y), O[3] * bfhi(gw.y));
    *(v2u*)(AO + qoff) = w;
}
}

struct Args { const float* in[24]; float* out; unsigned char* ws; int ph_lo, ph_hi, li, mode; };
__global__ void __launch_bounds__(NWAVES * 64, 2) yoco_fwd(Args args) {
    extern __shared__ __attribute__((aligned(16))) unsigned char lds_raw[];
    LAS unsigned char* lds = (LAS unsigned char*)lds_raw;
    volatile LAS unsigned* MISC = (volatile LAS unsigned*)(lds + MISC_OFF);
    const int tid0 = threadIdx.x;
    const int G = gridDim.x; const int bx = blockIdx.x; const int vcu = (G % 8 == 0) ? (bx % 8) * (G / 8) + bx / 8 : bx;
    unsigned char* ws = args.ws; float* out = args.out;
    gu32* ctl = (gu32*)(ws + WS_CTL);
    const float* x_prompt = args.in[0]; const float* x_sample = args.in[1]; const float* cache_k = args.in[2]; const float* cache_v = args.in[3];
    const float* state_conv = args.in[4]; const float* state_h = args.in[5]; const int* page_table = (const int*)args.in[6];
    const float* g_pre = args.in[7]; const float* g_post = args.in[8]; const float* a_w_in = args.in[9]; const float* a_conv_w = args.in[10]; const float* a_conv_b = args.in[11];
    const float* a_w_r = args.in[12]; const float* a_b_r = args.in[13]; const float* a_w_i = args.in[14]; const float* a_b_i = args.in[15]; const float* a_lambda = args.in[16];
    const float* a_w_out = args.in[17]; const float* kv_norm = args.in[18]; const float* w_k = args.in[19]; const float* w_v = args.in[20]; const float* b_w_in = args.in[21];
    const float* b_logit = args.in[22]; const float* b_w_out = args.in[23];
    bf16* W1T = (bf16*)(ws + WS_W1T); bf16* WGT = (bf16*)(ws + WS_WGT); bf16* W3T = (bf16*)(ws + WS_W3T); bf16* W4T = (bf16*)(ws + WS_W4T); bf16* W5T = (bf16*)(ws + WS_W5T);
    float* CL = (float*)(ws + WS_CL); float* SA = (float*)(ws + WS_SA); float* SB = (float*)(ws + WS_SB); float* LT = (float*)(ws + WS_LT); float* PO = (float*)(ws + WS_PO); float* XB = (float*)(ws + WS_XB); float* SQ2 = (float*)(ws + WS_SQ2);
    bf16* XN = (bf16*)(ws + WS_XN); bf16* XR = (bf16*)(ws + WS_XR); bf16* GT = (bf16*)(ws + WS_GT); bf16* XC = (bf16*)(ws + WS_XC); bf16* Y = (bf16*)(ws + WS_Y);
    unsigned* AB = (unsigned*)(ws + WS_AL); bf16* OUTB = (bf16*)(ws + WS_OUT); float* OUTS = (float*)(ws + WS_OUTS); bf16* X1B = (bf16*)(ws + WS_X1);
    bf16* KB = (bf16*)(ws + WS_KB); bf16* VT = (bf16*)(ws + WS_VT); bf16* QB = (bf16*)(ws + WS_QB); bf16* G2 = (bf16*)(ws + WS_G2); bf16* AO = (bf16*)(ws + WS_AO);

    for (int u = tid0; u < (LDS_BYTES - LDSCTL_OFF) / 4; u += NWAVES * 64) ((LAS unsigned*)(lds + LDSCTL_OFF))[u] = 0u;
    __syncthreads();
    const int lo = args.ph_lo, hi = args.ph_hi;
    XcdBarrier bar; bar.bar = (unsigned*)(ctl + CW_BAR) + args.li * XCD_BAR_WORDS; bar.x = 0; bar.st = nullptr;
    if (hi - lo > 1) bar = xcd_barrier_post((unsigned*)(ctl + CW_BAR) + args.li * XCD_BAR_WORDS, MISC + 8);
#define GRID_BAR() xcd_barrier(bar)
#ifndef TEST_ONLY_PHASE
#define TEST_ONLY_PHASE -1
#endif
#define IN(k) ((TEST_ONLY_PHASE < 0 || TEST_ONLY_PHASE == (k)) && lo <= (k) && (k) < hi)
#define BOTH(k) (IN(k) && IN((k) + 1))
    const int NGW = G * NWAVES, NGT = G * NWAVES * 64;
#define EARLY_S(G_, bx_) ((G_) == 256 && (bx_) >= 660 - 2 * 256)
#define PHASE_IDS() int tid_p = threadIdx.x; asm volatile("" : "+v"(tid_p)); const int tid = tid_p, lane = tid & 63, wave = __builtin_amdgcn_readfirstlane(tid >> 6), gw = vcu * NWAVES + wave, gt = vcu * (NWAVES * 64) + tid; (void)lane; (void)gw; (void)gt

    if (IN(0)) {
        PHASE_IDS();
        LAS float* scr = (LAS float*)(lds + RING_OFF + wave * 16384);
        constexpr int I_W1 = 32 * 160, I_WG = 40 * 16, NITEMS = I_W1 + I_WG;
        for (int it = gw; it < NITEMS; it += NGW) {
            int r = it;
            if (r < I_W1) { tr_item(a_w_in, 5120, 2048, 160, W1T, r, g_pre, 1.0f, scr, lane); continue; } r -= I_W1;
            const int sm = r >> 4, hb = sm >> 1, gi = sm & 1, nb = hb >> 1, hf = hb & 1;
            tr_item((gi ? a_w_i : a_w_r) + (size_t)nb * 65536 + 128 * hf, 256, 256, 4, WGT + (size_t)(hb * 256 + gi * 128) * 256, r & 15, nullptr, 1.0f, scr, lane);
        }
        for (int ch = gt; ch < DR; ch += NGT) CL[ch] = -8.0f * LOG2E * log1pf(expf(-a_lambda[ch]));
        for (int m = gw; m < MPAD; m += NGW) {
            bf16* orow = XN + (size_t)m * DM;
            if (m < MREAL) { const float* xr = (m < MPROMPT) ? x_prompt + (size_t)m * DM : x_sample + (size_t)(m - MPROMPT) * DM;
                f32x4 v[8]; load_row8(xr, lane, v); const float rs = 1.0f / sqrtf(wave_sum(sumsq8(v)) * (1.0f / DM) + EPS); store_row8_bf16(orow, lane, v, rs); }
            else {
#pragma unroll
                for (int j = 0; j < 8; ++j) ((v2u*)orow)[64 * j + lane] = (v2u){0u, 0u}; }
        }
        if (BOTH(0)) GRID_BAR();
    }
    if (IN(1)) {
        pg8::Gemm g{2048, 2048}; pg8::Order S; S.init(XN, W1T, 2048, 2048, 32, 20, 2048, 1, 32, 0, G, bx);
        EpiG1 E{XR, GT};
        pg8::gemm_phase<EpiG1, pg8::Order, true, true>(lds + RING_OFF, g, S, E);
        const int nbusy = (S.nP + S.nS) - ((S.nP + S.nS - 1) / G) * G;
        if (bx >= nbusy) {
            int tid_d = threadIdx.x; asm volatile("" : "+v"(tid_d)); const int lane_d = tid_d & 63, wave_d = __builtin_amdgcn_readfirstlane(tid_d >> 6);
            LAS float* scr = (LAS float*)(lds + RING_OFF + wave_d * 16384);
            constexpr int I_W3 = 40 * 64, I_WK = 32 * 16, I_WQ = 32 * 64, I_W5 = 32 * 64, NDEF = I_W3 + 2 * I_WK + 2 * I_WQ + I_W5;
            for (int it = (bx - nbusy) * NWAVES + wave_d; it < NDEF; it += (G - nbusy) * NWAVES) {
                int r = it;
                if (r < I_W3) { tr_item(a_w_out, 2048, 2560, 64, W3T, r, nullptr, 1.0f, scr, lane_d); continue; } r -= I_W3;
                if (r < I_WK) { tr_item(w_k, 512, 2048, 16, W4T, r, kv_norm, 1.0f, scr, lane_d); continue; } r -= I_WK;
                if (r < I_WK) { tr_item(w_v, 512, 2048, 16, W4T + (size_t)512 * 2048, r, kv_norm, 1.0f, scr, lane_d); continue; } r -= I_WK;
                if (r < I_WQ) { tr_item(b_w_in, 4096, 2048, 64, W4T + (size_t)1024 * 2048, r, g_pre + DM, QSCALE, scr, lane_d); continue; } r -= I_WQ;
                if (r < I_WQ) { tr_item(b_w_in + 2048, 4096, 2048, 64, W4T + (size_t)3072 * 2048, r, g_pre + DM, 1.0f, scr, lane_d); continue; } r -= I_WQ;
                tr_item(b_w_out, 2048, 2048, 64, W5T, r, nullptr, 1.0f, scr, lane_d);
            }
        }
        if (BOTH(1)) GRID_BAR();
    }
    if (IN(2)) {
        PHASE_IDS();
        for (int task = gt; task < 256 * 320 + 32 * 320; task += NGT) {
            const bool samp = task >= 256 * 320; const int tk = samp ? task - 256 * 320 : task; const int rb = tk / 320, cg = tk % 320, ch = 8 * cg;
            float w[4][8], cb[8], x3[8], x2[8], x1[8];
#pragma unroll
            for (int k = 0; k < 4; ++k) { const f32x4 a = *(const f32x4*)(a_conv_w + k * DR + ch), b = *(const f32x4*)(a_conv_w + k * DR + ch + 4);
                w[k][0] = a.x; w[k][1] = a.y; w[k][2] = a.z; w[k][3] = a.w; w[k][4] = b.x; w[k][5] = b.y; w[k][6] = b.z; w[k][7] = b.w; }
            { const f32x4 a = *(const f32x4*)(a_conv_b + ch), b = *(const f32x4*)(a_conv_b + ch + 4); cb[0] = a.x; cb[1] = a.y; cb[2] = a.z; cb[3] = a.w; cb[4] = b.x; cb[5] = b.y; cb[6] = b.z; cb[7] = b.w; }
            int m0, nrows;
            if (!samp) { m0 = 32 * rb; nrows = 32;
                if ((m0 & 4095) != 0) { unpack8(*(const v4u*)(XR + (size_t)(m0 - 3) * DR + ch), x3); unpack8(*(const v4u*)(XR + (size_t)(m0 - 2) * DR + ch), x2); unpack8(*(const v4u*)(XR + (size_t)(m0 - 1) * DR + ch), x1); }
                else {
#pragma unroll
                    for (int j = 0; j < 8; ++j) { x3[j] = 0.f; x2[j] = 0.f; x1[j] = 0.f; } }
            } else { m0 = MPROMPT + 4 * rb; nrows = 4; const float* sc = state_conv + (size_t)rb * 3 * DR + ch;
#pragma unroll
                for (int j = 0; j < 8; ++j) { x3[j] = sc[j]; x2[j] = sc[DR + j]; x1[j] = sc[2 * DR + j]; } }
            for (int r0 = 0; r0 < nrows; r0 += 4) {
                v4u xw[4];
#pragma unroll
                for (int i = 0; i < 4; ++i) xw[i] = *(const v4u*)(XR + (size_t)(m0 + r0 + i) * DR + ch);
#pragma unroll
                for (int i = 0; i < 4; ++i) {
                    float x0[8]; unpack8(xw[i], x0);
                    float xc[8];
#pragma unroll
                    for (int j = 0; j < 8; ++j) { xc[j] = cb[j] + w[0][j] * x3[j] + w[1][j] * x2[j] + w[2][j] * x1[j] + w[3][j] * x0[j]; x3[j] = x2[j]; x2[j] = x1[j]; x1[j] = x0[j]; }
                    v4u o; o.x = pk2(xc[0], xc[1]); o.y = pk2(xc[2], xc[3]); o.z = pk2(xc[4], xc[5]); o.w = pk2(xc[6], xc[7]);
                    *(v4u*)(XC + (size_t)(m0 + r0 + i) * DR + ch) = o;
                }
            }
            float* so = nullptr;
            if (samp) so = out + O_CVS + (size_t)rb * 3 * DR + ch;
            else if (((m0 + 32) & 4095) == 0) so = out + O_CVP + (size_t)(m0 >> 12) * 3 * DR + ch;
            if (so) {
#pragma unroll
                for (int j = 0; j < 8; ++j) { so[j] = x3[j]; so[DR + j] = x2[j]; so[2 * DR + j] = x1[j]; } }
        }
        if (BOTH(2)) GRID_BAR();
    }
    if (IN(3)) {
        pg8::Gemm g{DR, 256}; pg8::Order S; S.init(XC, WGT, DR, 256, 32, 20, 256, 1, 32, 1, G, bx);
        EpiLru E{XC, AB, a_b_r, a_b_i, CL, SA, SB, (LAS float*)(lds + LDSCTL_OFF + 1024)};
        pg8::gemm_phase<EpiLru, pg8::Order, true, true>(lds + RING_OFF, g, S, E);
        if (BOTH(3)) GRID_BAR();
    }
    if (IN(5)) {
        PHASE_IDS();
        for (int task = gt; task < 96 * (DR / 2); task += NGT) {
            if (task >= 64 * (DR / 2)) {
                const int ts = task - 64 * (DR / 2), sb = ts / (DR / 2), ch = 2 * (ts % (DR / 2)); const f32x2_t h0s = *(const f32x2_t*)(state_h + (size_t)sb * DR + ch); float h[2] = {h0s.x, h0s.y};
#pragma unroll
                for (int i = 0; i < 4; ++i) { const size_t o = (size_t)(MPROMPT + sb * 4 + i) * DR + ch; const v2u w = *(const v2u*)(AB + o); const unsigned g = *(const unsigned*)(GT + o);
                    h[0] = ex2(bflo(w.x)) * h[0] + bfhi(w.x); h[1] = ex2(bflo(w.y)) * h[1] + bfhi(w.y); *(unsigned*)(Y + o) = pk2(h[0] * bflo(g), h[1] * bfhi(g)); }
                *(f32x2_t*)(out + O_HS + (size_t)sb * DR + ch) = (f32x2_t){h[0], h[1]};
                continue; }
            const int bc = task / (DR / 2), ch = 2 * (task % (DR / 2)), b = bc >> 5, c = bc & 31; const size_t m0 = (size_t)b * SEQ + c * 128;
            float h0 = 0.f, h1 = 0.f;
            for (int cc0 = 0; cc0 < c; cc0 += 8) {
                f32x2_t sa[8], sb2[8];
#pragma unroll
                for (int j = 0; j < 8; ++j) { const int cc = (cc0 + j < c) ? cc0 + j : c - 1; sa[j] = *(const f32x2_t*)(SA + (size_t)(b * 32 + cc) * DR + ch); sb2[j] = *(const f32x2_t*)(SB + (size_t)(b * 32 + cc) * DR + ch); }
#pragma unroll
                for (int j = 0; j < 8; ++j) if (cc0 + j < c) { h0 = sa[j].x * h0 + sb2[j].x; h1 = sa[j].y * h1 + sb2[j].y; } }
            const unsigned* ap = AB + m0 * DR + ch; const bf16* gp = GT + m0 * DR + ch; bf16* yp = Y + m0 * DR + ch;
            for (int t = 0; t < 128; t += 16) { v2u w[16]; unsigned gg[16];
#pragma unroll
                for (int j = 0; j < 16; ++j) { w[j] = *(const v2u*)(ap + (size_t)(t + j) * DR); gg[j] = *(const unsigned*)(gp + (size_t)(t + j) * DR); }
#pragma unroll
                for (int j = 0; j < 16; ++j) { h0 = ex2(bflo(w[j].x)) * h0 + bfhi(w[j].x); h1 = ex2(bflo(w[j].y)) * h1 + bfhi(w[j].y); *(unsigned*)(yp + (size_t)(t + j) * DR) = pk2(h0 * bflo(gg[j]), h1 * bfhi(gg[j])); } }
            if (c == 31) *(f32x2_t*)(out + O_HP + (size_t)b * DR + ch) = (f32x2_t){h0, h1};
        }
        if (BOTH(5)) GRID_BAR();
    }
    if (IN(6)) {
        unsigned* sga = (unsigned*)(ctl + CW_SGA);
        pg8::Gemm g{DR, DR}; pg8::Order S; S.init(Y, W3T, DR, DR, 32, 8, DR, 10, 32, 0, G, bx);
        S.sig = sga; S.sig_lo = 0; S.sig_hi = 8; S.sig_wg = true;
        EpiNorm<0> E{ws, x_prompt, nullptr, g_post, args.li, (LAS float*)(lds + LDSCTL_OFF + 1024)};
        pg8::gemm_phase<EpiNorm<0>, pg8::Order, true, true>(lds + RING_OFF, g, S, E);
        if (bx >= G - 128) {
            PHASE_IDS();
            LAS float* red = (LAS float*)(lds + LDSCTL_OFF + 1024);
            if (wave == 0) { for (unsigned sp = 0; __hip_atomic_load(sga, __ATOMIC_RELAXED, __HIP_MEMORY_SCOPE_AGENT) < 80u && sp < (1u << 20); ++sp) __builtin_amdgcn_s_sleep(2);
                __builtin_amdgcn_fence(__ATOMIC_ACQUIRE, "agent"); asm volatile("s_waitcnt vmcnt(0)" ::: "memory"); }
            __syncthreads();
            const int ms = bx - (G - 128), m = MPROMPT + ms, c4 = wave * 256 + lane * 4;
            f32x4 t[10];
#pragma unroll
            for (int sp = 0; sp < 10; ++sp) t[sp] = *(const f32x4*)(OUTS + ((size_t)sp * 256 + ms) * DM + c4);
            const f32x4 xv = *(const f32x4*)(x_sample + (size_t)ms * DM + c4), gv = *(const f32x4*)(g_post + c4);
            f32x4 o = t[0];
#pragma unroll
            for (int sp = 1; sp < 10; ++sp) o += t[sp];
            const float q = wave_sum((o[0] * o[0] + o[1] * o[1]) + (o[2] * o[2] + o[3] * o[3]));
            if (lane == 0) red[wave] = q;
            __syncthreads();
            const float rs = 1.0f / sqrtf((((red[0] + red[1]) + (red[2] + red[3])) + ((red[4] + red[5]) + (red[6] + red[7]))) * (1.0f / DM) + EPS);
            const f32x4 x1 = xv + o * rs * gv;
            *(v2u*)(X1B + (size_t)m * DM + c4) = (v2u){pk2(x1[0], x1[1]), pk2(x1[2], x1[3])};
            const float q2 = wave_sum((x1[0] * x1[0] + x1[1] * x1[1]) + (x1[2] * x1[2] + x1[3] * x1[3]));
            if (lane == 0) SQ2[(size_t)m * 8 + wave] = q2;
        }
        if (BOTH(6)) GRID_BAR();
    }
    if (IN(8)) {
        unsigned* sig = (unsigned*)(ctl + CW_SIG + 64 * args.li);
        pg8::Gemm g{2048, 2048}; pg8::Order S; S.init(X1B, W4T, 2048, 2048, 32, 20, 2048, 1, 32, 0, G, bx);
        S.sfirst = true; S.sig = sig; S.sig_lo = 4; S.sig_hi = 12;
        EpiG4 E{out, KB, VT, QB, G2, SQ2};
        pg8::gemm_phase<EpiG4, pg8::Order, true, true>(lds + RING_OFF, g, S, E);
        if (EARLY_S(G, bx)) {
            PHASE_IDS();
            for (unsigned sp = 0; __hip_atomic_load(sig, __ATOMIC_RELAXED, __HIP_MEMORY_SCOPE_AGENT) < 64u && sp < (1u << 20); ++sp) __builtin_amdgcn_s_sleep(2);
            __builtin_amdgcn_fence(__ATOMIC_ACQUIRE, "agent");
            asm volatile("s_waitcnt vmcnt(0)" ::: "memory");
            if (wave < 4) for (int g8 = gw; g8 < 2048; g8 += NGW) { const int j = g8 >> 2; sba::s_waveunit((((j >> 4) * 4 + (g8 & 3)) << 4) | (j & 15), cache_k, cache_v, page_table, QB, b_logit, PO, LT, lds + RING_OFF + wave * 8704); }
        }
        if (BOTH(8)) GRID_BAR();
    }
    if (IN(9)) {
        PHASE_IDS();
        const int spos = (vcu % 5 == 0) ? 0 : (vcu % 5 == 4) ? 2 : 1;
        const bool early = EARLY_S(G, bx);
        for (int step = 0; step < 3; ++step) {
            if (step == spos && !(args.mode & 1) && (!early || wave >= 4)) for (int g8 = gw; g8 < 2048; g8 += NGW) { const int j = g8 >> 2; sba::s_waveunit((((j >> 4) * 4 + (g8 & 3)) << 4) | (j & 15), cache_k, cache_v, page_table, QB, b_logit, PO, LT, lds + RING_OFF + wave * 8704); }
            if (step == spos && !(args.mode & 1)) __syncthreads();
            if (step < 2 && !(args.mode & 2)) {
                if (G == 256) {
                    const int x = vcu >> 5, j = vcu & 31, t = j >> 2, b = x >> 2, h = (x & 3) * 4 + (j & 3);
                    const int qa = (t == 0) ? 13 : (t == 1) ? 12 : (t == 2) ? 11 : (t == 3) ? 8 : (t == 4) ? 7 : (t == 5) ? 15 : (t == 6) ? 14 : 10;
                    const int qc = (t == 0) ? 0 : (t == 1) ? 1 : (t == 2) ? 2 : (t == 3) ? 5 : (t == 4) ? 6 : (t == 5) ? 3 : (t == 6) ? 4 : 9;
                    const float bias2 = b_logit[h] * LOG2E; const bool longfirst = (j & 1) == 0;
                    sba::p_unit(b, h, ((step == 0) == longfirst) ? qa : qc, QB, KB, VT, G2, AO, bias2, lds + RING_OFF);
                } else for (int pu = vcu; pu < 256; pu += G) {
                    const int bh = pu >> 3, s = pu & 7, b = bh >> 4, h = bh & 15; const float bias2 = b_logit[h] * LOG2E; const bool longfirst = (pu & 1) == 0;
                    sba::p_unit(b, h, ((step == 0) == longfirst) ? 15 - s : s, QB, KB, VT, G2, AO, bias2, lds + RING_OFF);
                }
            }
        }
        if (BOTH(9)) GRID_BAR();
    }
    if (IN(11)) {
        unsigned* cmb = (unsigned*)(ctl + CW_CMB + 64 * args.li);
        { PHASE_IDS();
          const int half = G / 2; int ndone = 0;
          if (bx >= half) for (int pair = bx - half; pair < 128; pair += G - half) { sba::s_combine(pair, out, QB, G2, b_logit, PO, LT, AO); ++ndone; }
          if (ndone) { asm volatile("s_waitcnt vmcnt(0)" ::: "memory"); __syncthreads();
              if (tid == 0) { __builtin_amdgcn_fence(__ATOMIC_RELEASE, "agent"); asm volatile("s_waitcnt vmcnt(0)" ::: "memory"); (void)__hip_atomic_fetch_add(cmb, (unsigned)ndone, __ATOMIC_RELAXED, __HIP_MEMORY_SCOPE_AGENT); } } }
        unsigned* sgb = (unsigned*)(ctl + CW_SGB);
        pg8::Gemm g{DM, DM}; pg8::Order S; S.init(AO, W5T, DM, DM, 32, 8, DM, 8, 32, 0, G, bx);
        S.wait_cnt = cmb; S.wait_n = 128u;
        S.sig = sgb; S.sig_lo = 0; S.sig_hi = 8; S.sig_wg = true;
        EpiNorm<1> E{ws, nullptr, out + O_YP, g_post + DM, args.li, (LAS float*)(lds + LDSCTL_OFF + 1024)};
        pg8::gemm_phase<EpiNorm<1>, pg8::Order, true, true>(lds + RING_OFF, g, S, E);
        if (bx >= G - 128) {
            PHASE_IDS();
            LAS float* red = (LAS float*)(lds + LDSCTL_OFF + 1024);
            if (wave == 0) { for (unsigned sp = 0; __hip_atomic_load(sgb, __ATOMIC_RELAXED, __HIP_MEMORY_SCOPE_AGENT) < 64u && sp < (1u << 20); ++sp) __builtin_amdgcn_s_sleep(2);
                __builtin_amdgcn_fence(__ATOMIC_ACQUIRE, "agent"); asm volatile("s_waitcnt vmcnt(0)" ::: "memory"); }
            __syncthreads();
            const int ms = bx - (G - 128), m = MPROMPT + ms, c4 = wave * 256 + lane * 4;
            f32x4 t[8];
#pragma unroll
            for (int sp = 0; sp < 8; ++sp) t[sp] = *(const f32x4*)(OUTS + ((size_t)sp * 256 + ms) * DM + c4);
            const v2u xw = *(const v2u*)(X1B + (size_t)m * DM + c4); const f32x4 gv = *(const f32x4*)(g_post + DM + c4);
            f32x4 o = t[0];
#pragma unroll
            for (int sp = 1; sp < 8; ++sp) o += t[sp];
            const float q = wave_sum((o[0] * o[0] + o[1] * o[1]) + (o[2] * o[2] + o[3] * o[3]));
            if (lane == 0) red[wave] = q;
            __syncthreads();
            const float rs = 1.0f / sqrtf((((red[0] + red[1]) + (red[2] + red[3])) + ((red[4] + red[5]) + (red[6] + red[7]))) * (1.0f / DM) + EPS);
            *(f32x4*)(out + O_YS + (size_t)ms * DM + c4) = (f32x4){bflo(xw.x), bfhi(xw.x), bflo(xw.y), bfhi(xw.y)} + o * rs * gv;
        }
    }
#undef IN
#undef BOTH
#undef GRID_BAR
}

extern "C" void kernel_launch(void* const* d_in, const int* in_sizes, int n_in, void* d_out, int out_size, void* d_ws, size_t ws_size, hipStream_t stream) {
    static int grid = 0;
    if (grid == 0) {
        if (n_in != 24 || (size_t)out_size != O_END || ws_size < WS_END) { fprintf(stderr, "kernel_launch: unexpected shapes: n_in %d out %d ws %zu\n", n_in, out_size, ws_size); grid = -1; return; }
        int dev = 0, cus = 0, per_cu = 0;
        if (hipGetDevice(&dev) != hipSuccess || hipDeviceGetAttribute(&cus, hipDeviceAttributeMultiprocessorCount, dev) != hipSuccess) { grid = -1; return; }
        if (hipFuncSetAttribute((const void*)yoco_fwd, hipFuncAttributeMaxDynamicSharedMemorySize, LDS_BYTES) != hipSuccess) { fprintf(stderr, "kernel_launch: hipFuncSetAttribute failed\n"); grid = -1; return; }
        if (hipOccupancyMaxActiveBlocksPerMultiprocessor(&per_cu, (const void*)yoco_fwd, NWAVES * 64, LDS_BYTES) != hipSuccess || per_cu < 1)
            fprintf(stderr, "kernel_launch: occupancy query reports %d workgroups per CU\n", per_cu);
        (void)hipGetLastError();
        grid = cus;
    }
    if (grid < 0) return;
    if (hipMemsetAsync((char*)d_ws + WS_CTL, 0, CTL_ZERO_BYTES, stream) != hipSuccess) return;
    Args a{};
    for (int i = 0; i < 24; ++i) a.in[i] = (const float*)d_in[i];
    a.out = (float*)d_out; a.ws = (unsigned char*)d_ws;
    if (N_LAUNCHES == 1) { a.ph_lo = 0; a.ph_hi = NPHASE; a.li = 0; hipLaunchKernelGGL(yoco_fwd, dim3(grid), dim3(NWAVES * 64), LDS_BYTES, stream, a); }
    else for (int p = 0; p < NPHASE; ++p) { a.ph_lo = p; a.ph_hi = p + 1; a.li = p; hipLaunchKernelGGL(yoco_fwd, dim3(grid), dim3(NWAVES * 64), LDS_BYTES, stream, a); }
#ifdef PROBE_EXTRA
    { const int extra[] = {PROBE_EXTRA}; int li = 20;
      for (int pe : extra) { const int p = pe % 100; a.mode = pe / 100; a.ph_lo = p; a.ph_hi = p + 1; a.li = li++; hipLaunchKernelGGL(yoco_fwd, dim3(grid), dim3(NWAVES * 64), LDS_BYTES, stream, a); } }
#endif
}
```
